# Optimizing an MI355X kernel written in HIP

```python
import numpy as np
import jax
import jax.numpy as jnp
from jax import lax

D_MODEL = 1024
BATCH = 8
SEQ = 2048
DEPTH = 4

HEAD_DIM = 64
FOX_HEADS = 4
NSA_HEADS = 6
NSA_KV_HEADS = 2
DSA_HEADS = 6
MIX_WIDTH = (FOX_HEADS + NSA_HEADS + DSA_HEADS) * HEAD_DIM
ROPE_THETA = 10000.0
Q_BLOCK = 128
NSA_Q_BLOCK = 64
CMP_LEN = 32
CMP_STRIDE = 16
CMP_HIDDEN = 2 * HEAD_DIM
SEL_BLOCK = 64
SEL_TOPN = 16
WINDOW = 512
IDX_HEADS = 4
IDX_DIM = 64
DSA_TOPK = 256
N_EXPERTS = 64
N_GROUPS = 8
TOPK_GROUPS = 4
MOE_TOPK = 8
EXPERT_DIM = 256
SHARED_DIM = 256
ROUTED_SCALE = 2.5
MOE_BLOCK = 256
ALPHA = (2 * DEPTH) ** 0.25
BETA = (8 * DEPTH) ** -0.25
LN_EPS = 1e-5
NEG = -1e30
FORCE = 1e6

SEGMENTS = (
    ('fox_q', FOX_HEADS * HEAD_DIM), ('fox_k', FOX_HEADS * HEAD_DIM),
    ('fox_v', FOX_HEADS * HEAD_DIM), ('fox_f', FOX_HEADS),
    ('nsa_q', NSA_HEADS * HEAD_DIM),
    ('nsa_kc', NSA_KV_HEADS * HEAD_DIM), ('nsa_vc', NSA_KV_HEADS * HEAD_DIM),
    ('nsa_ks', NSA_KV_HEADS * HEAD_DIM), ('nsa_vs', NSA_KV_HEADS * HEAD_DIM),
    ('nsa_kw', NSA_KV_HEADS * HEAD_DIM), ('nsa_vw', NSA_KV_HEADS * HEAD_DIM),
    ('nsa_g', 3 * NSA_HEADS),
    ('dsa_q', DSA_HEADS * HEAD_DIM), ('dsa_k', HEAD_DIM), ('dsa_v', HEAD_DIM),
    ('idx_q', IDX_HEADS * IDX_DIM), ('idx_k', IDX_DIM), ('idx_w', IDX_HEADS),
)
N_IN = sum(width for _, width in SEGMENTS)

kernel_name = 'hybrid_fox_nsa_dsa_moe_deepnorm'


def _split_columns(h):
    parts, off = {}, 0
    for name, width in SEGMENTS:
        parts[name] = h[..., off:off + width]
        off += width
    return parts


def _rope(x, pos):
    d = x.shape[-1]
    half = d // 2
    inv_freq = ROPE_THETA ** (-jnp.arange(half, dtype=jnp.float32) * (2.0 / d))
    ang = pos.astype(jnp.float32)[:, None] * inv_freq[None, :]
    cos = jnp.cos(ang)[:, None, :]
    sin = jnp.sin(ang)[:, None, :]
    xf = x.astype(jnp.float32)
    x1, x2 = xf[..., :half], xf[..., half:]
    return jnp.concatenate([x1 * cos - x2 * sin, x2 * cos + x1 * sin], axis=-1).astype(x.dtype)


def _layer_norm(x, g, b):
    xf = x.astype(jnp.float32)
    mu = jnp.mean(xf, -1, keepdims=True)
    var = jnp.mean(jnp.square(xf - mu), -1, keepdims=True)
    return ((xf - mu) * lax.rsqrt(var + LN_EPS) * g + b).astype(x.dtype)


def _block_stack(y, batch, seq):
    y = jnp.moveaxis(y, 0, 1)
    return y.reshape((batch, seq) + y.shape[3:])


def _fox_attention(q, k, v, f_logit, f_bias):
    B, T, H, D = q.shape
    scale = D ** -0.5
    log_f = jax.nn.log_sigmoid((f_logit + f_bias).astype(jnp.float32))
    c = jnp.cumsum(log_f, axis=1).transpose(0, 2, 1)
    pos = jnp.arange(T)

    def sweep(i):
        q0 = i * Q_BLOCK
        tq = q0 + jnp.arange(Q_BLOCK)
        qb = lax.dynamic_slice_in_dim(q, q0, Q_BLOCK, axis=1)
        cb = lax.dynamic_slice_in_dim(c, q0, Q_BLOCK, axis=2)
        s = jnp.einsum('bqhd,bkhd->bhqk', qb, k).astype(jnp.float32) * scale
        s = s + (cb[..., :, None] - c[..., None, :])
        s = jnp.where(pos[None, :] <= tq[:, None], s, NEG)
        p = jax.nn.softmax(s, axis=-1).astype(v.dtype)
        return jnp.einsum('bhqk,bkhd->bqhd', p, v)

    return _block_stack(lax.map(sweep, jnp.arange(T // Q_BLOCK)), B, T)


def _compress(tok, pe, w1, w2):
    B, T, G, D = tok.shape
    n_c = (T - CMP_LEN) // CMP_STRIDE + 1
    idx = np.arange(n_c)[:, None] * CMP_STRIDE + np.arange(CMP_LEN)[None, :]
    blk = tok[:, idx] + pe[:, None, :]
    blk = jnp.swapaxes(blk, 2, 3).reshape(B, n_c, G, CMP_LEN * D)
    return jax.nn.gelu(blk @ w1) @ w2


def _nsa_attention(q, kc, vc, ks, vs, kw, vw, gate_logits, cpk, c1k, c2k, cpv, c1v, c2v):
    B, T, H, D = q.shape
    G = kc.shape[2]
    R = H // G
    scale = D ** -0.5
    pos = jnp.arange(T)
    qg = q.reshape(B, T, G, R, D)

    k_cmp = _compress(kc, cpk, c1k, c2k)
    v_cmp = _compress(vc, cpv, c1v, c2v)
    n_c = k_cmp.shape[1]
    c_start = np.arange(n_c) * CMP_STRIDE
    vis_c = (c_start + CMP_LEN - 1)[None, :] <= pos[:, None]
    s_c = jnp.einsum('btgrd,bcgd->bgrtc', qg, k_cmp).astype(jnp.float32) * scale
    p_c = jax.nn.softmax(jnp.where(vis_c, s_c, NEG), axis=-1) * jnp.any(vis_c, -1)[:, None]
    o_cmp = jnp.einsum('bgrtc,bcgd->btgrd', p_c.astype(v_cmp.dtype), v_cmp)

    n_s = T // SEL_BLOCK
    b_start = np.arange(n_s) * SEL_BLOCK
    overlap = ((c_start[:, None] < b_start[None, :] + SEL_BLOCK)
               & (c_start[:, None] + CMP_LEN > b_start[None, :])).astype(np.float32)
    imp = jnp.einsum('bgrtc,cs->bgts', p_c, jnp.asarray(overlap))
    blk_t = (pos // SEL_BLOCK)[:, None]
    jj = jnp.arange(n_s)[None, :]
    forced = (jj == 0) | (jj == blk_t) | (jj == blk_t - 1)
    imp = jnp.where(jj <= blk_t, jnp.where(forced, FORCE, imp), -1.0)
    n_top = min(SEL_TOPN, n_s)
    _, sel = lax.top_k(imp, n_top)

    ks_blk = ks.reshape(B, n_s, SEL_BLOCK, G, D).transpose(0, 3, 1, 2, 4)
    vs_blk = vs.reshape(B, n_s, SEL_BLOCK, G, D).transpose(0, 3, 1, 2, 4)
    kw_pad = jnp.pad(kw, ((0, 0), (WINDOW, 0), (0, 0), (0, 0)))
    vw_pad = jnp.pad(vw, ((0, 0), (WINDOW, 0), (0, 0), (0, 0)))
    gather = jax.vmap(jax.vmap(lambda blocks, ids: blocks[ids]))
    n_keys = n_top * SEL_BLOCK

    def sweep(i):
        q0 = i * NSA_Q_BLOCK
        tq = q0 + jnp.arange(NSA_Q_BLOCK)
        qb = lax.dynamic_slice_in_dim(qg, q0, NSA_Q_BLOCK, axis=1)
        selb = lax.dynamic_slice_in_dim(sel, q0, NSA_Q_BLOCK, axis=2)
        kg = gather(ks_blk, selb).reshape(B, G, NSA_Q_BLOCK, n_keys, D)
        vg = gather(vs_blk, selb).reshape(B, G, NSA_Q_BLOCK, n_keys, D)
        tk = (selb[..., None] * SEL_BLOCK + jnp.arange(SEL_BLOCK)).reshape(B, G, NSA_Q_BLOCK, n_keys)
        s = jnp.einsum('bqgrd,bgqkd->bgrqk', qb, kg).astype(jnp.float32) * scale
        s = jnp.where((tk <= tq[:, None])[:, :, None], s, NEG)
        o_slc = jnp.einsum('bgrqk,bgqkd->bqgrd', jax.nn.softmax(s, axis=-1).astype(vg.dtype), vg)
        kwb = lax.dynamic_slice_in_dim(kw_pad, q0, WINDOW + NSA_Q_BLOCK, axis=1)
        vwb = lax.dynamic_slice_in_dim(vw_pad, q0, WINDOW + NSA_Q_BLOCK, axis=1)
        tw = q0 - WINDOW + jnp.arange(WINDOW + NSA_Q_BLOCK)
        dist = tq[:, None] - tw[None, :]
        band = (dist >= 0) & (dist < WINDOW) & (tw >= 0)[None, :]
        s_w = jnp.einsum('bqgrd,bkgd->bgrqk', qb, kwb).astype(jnp.float32) * scale
        p_w = jax.nn.softmax(jnp.where(band, s_w, NEG), axis=-1).astype(vwb.dtype)
        o_win = jnp.einsum('bgrqk,bkgd->bqgrd', p_w, vwb)
        return o_slc, o_win

    o_slc, o_win = lax.map(sweep, jnp.arange(T // NSA_Q_BLOCK))
    o_slc = _block_stack(o_slc, B, T)
    o_win = _block_stack(o_win, B, T)
    g = jax.nn.sigmoid(gate_logits).reshape(B, T, 3, G, R, 1)
    return g[:, :, 0] * o_cmp + g[:, :, 1] * o_slc + g[:, :, 2] * o_win


def _dsa_attention(q, k, v, iq, ik, iw):
    B, T, H, D = q.shape
    scale = D ** -0.5
    topk = min(DSA_TOPK, T // 4)
    w_idx = iw.astype(jnp.float32) * (IDX_HEADS ** -0.5) * (IDX_DIM ** -0.5)
    pos = jnp.arange(T)
    gather = jax.vmap(lambda rows, ids: rows[ids])

    def sweep(i):
        q0 = i * Q_BLOCK
        tq = q0 + jnp.arange(Q_BLOCK)
        iqb = lax.dynamic_slice_in_dim(iq, q0, Q_BLOCK, axis=1)
        iwb = lax.dynamic_slice_in_dim(w_idx, q0, Q_BLOCK, axis=1)
        dots = jnp.einsum('bqhe,bke->bqhk', iqb, ik).astype(jnp.float32)
        score = jnp.einsum('bqh,bqhk->bqk', iwb, jax.nn.relu(dots))
        score = jnp.where(pos[None, :] <= tq[:, None], score, NEG)
        _, idx = lax.top_k(score, topk)
        kg = gather(k, idx)
        vg = gather(v, idx)
        qb = lax.dynamic_slice_in_dim(q, q0, Q_BLOCK, axis=1)
        s = jnp.einsum('bqhd,bqkd->bhqk', qb, kg).astype(jnp.float32) * scale
        s = jnp.where((idx <= tq[None, :, None])[:, None], s, NEG)
        p = jax.nn.softmax(s, axis=-1).astype(vg.dtype)
        return jnp.einsum('bhqk,bqkd->bqhd', p, vg)

    return _block_stack(lax.map(sweep, jnp.arange(T // Q_BLOCK)), B, T)


def _heads(a, n_heads):
    return a.reshape(a.shape[0], a.shape[1], n_heads, -1)


def _token_mixer(x, w_in, fox_fb, cpk, c1k, c2k, cpv, c1v, c2v, w_out):
    B, T, _ = x.shape
    pos = jnp.arange(T)
    p = _split_columns(x @ w_in)
    G = NSA_KV_HEADS
    o_fox = _fox_attention(_heads(p['fox_q'], FOX_HEADS), _heads(p['fox_k'], FOX_HEADS),
                           _heads(p['fox_v'], FOX_HEADS), p['fox_f'], fox_fb)
    o_nsa = _nsa_attention(
        _rope(_heads(p['nsa_q'], NSA_HEADS), pos),
        _rope(_heads(p['nsa_kc'], G), pos), _heads(p['nsa_vc'], G),
        _rope(_heads(p['nsa_ks'], G), pos), _heads(p['nsa_vs'], G),
        _rope(_heads(p['nsa_kw'], G), pos), _heads(p['nsa_vw'], G),
        p['nsa_g'], cpk, c1k, c2k, cpv, c1v, c2v)
    o_dsa = _dsa_attention(
        _rope(_heads(p['dsa_q'], DSA_HEADS), pos),
        _rope(_heads(p['dsa_k'], 1), pos)[:, :, 0], p['dsa_v'],
        _rope(_heads(p['idx_q'], IDX_HEADS), pos),
        _rope(_heads(p['idx_k'], 1), pos)[:, :, 0], p['idx_w'])
    o = jnp.concatenate([o_fox.reshape(B, T, -1), o_nsa.reshape(B, T, -1),
                         o_dsa.reshape(B, T, -1)], axis=-1)
    return o @ w_out


def _moe(x, w_router, b_router, w_gate, w_up, w_down, ws_gate, ws_up, ws_down):
    B, T, Dm = x.shape
    N = B * T
    E = N_EXPERTS
    xt = x.reshape(N, Dm)
    s = jax.nn.sigmoid((xt @ w_router).astype(jnp.float32))
    sb = s + b_router.astype(jnp.float32)
    grp_score = lax.top_k(sb.reshape(N, N_GROUPS, E // N_GROUPS), 2)[0].sum(-1)
    _, gi = lax.top_k(grp_score, TOPK_GROUPS)
    gmask = jax.nn.one_hot(gi, N_GROUPS, dtype=jnp.float32).sum(1) > 0
    emask = jnp.repeat(gmask, E // N_GROUPS, axis=1)
    _, ei = lax.top_k(jnp.where(emask, sb, NEG), MOE_TOPK)
    gw = jnp.take_along_axis(s, ei, axis=1)
    gw = gw / jnp.sum(gw, -1, keepdims=True) * ROUTED_SCALE

    A = N * MOE_TOPK
    e_flat = ei.reshape(A)
    tok_flat = jnp.repeat(jnp.arange(N), MOE_TOPK)
    order = jnp.argsort(e_flat)
    e_s, tok_s, w_s = e_flat[order], tok_flat[order], gw.reshape(A)[order]
    counts = jnp.bincount(e_flat, length=E)
    start = jnp.cumsum(counts) - counts
    padded = (counts + MOE_BLOCK - 1) // MOE_BLOCK * MOE_BLOCK
    pstart = jnp.cumsum(padded) - padded
    dest = pstart[e_s] + (jnp.arange(A) - start[e_s])
    rows = A + E * MOE_BLOCK
    n_chunks = rows // MOE_BLOCK
    buf = jnp.zeros((rows, Dm), x.dtype).at[dest].set(xt[tok_s])
    chunk_e = jnp.minimum(jnp.searchsorted(pstart + padded, jnp.arange(n_chunks) * MOE_BLOCK, side='right'), E - 1)

    def expert_rows(args):
        xb, e = args
        h = jax.nn.silu(xb @ w_gate[e]) * (xb @ w_up[e])
        return h @ w_down[e]

    ybuf = lax.map(expert_rows, (buf.reshape(n_chunks, MOE_BLOCK, Dm), chunk_e)).reshape(rows, Dm)
    routed = jnp.zeros((N, Dm), x.dtype).at[tok_s].add(ybuf[dest] * w_s[:, None].astype(x.dtype))
    shared = (jax.nn.silu(xt @ ws_gate) * (xt @ ws_up)) @ ws_down
    return (routed + shared).reshape(B, T, Dm)


def setup_inputs(seed: int = 0) -> dict:
    key = jax.random.key(seed)
    ks = jax.random.split(key, 24)

    def nrm(k, shape, scale):
        return jax.random.normal(k, shape, jnp.float32) * scale

    L = DEPTH
    return {
        'x': nrm(ks[0], (BATCH, SEQ, D_MODEL), 1.0),
        'w_in': nrm(ks[1], (L, D_MODEL, N_IN), D_MODEL ** -0.5),
        'fox_forget_bias': 3.0 + nrm(ks[2], (L, FOX_HEADS), 0.5),
        'cmp_pos_k': nrm(ks[3], (L, CMP_LEN, HEAD_DIM), 0.1),
        'cmp_w1_k': nrm(ks[4], (L, CMP_LEN * HEAD_DIM, CMP_HIDDEN), (CMP_LEN * HEAD_DIM) ** -0.5),
        'cmp_w2_k': nrm(ks[5], (L, CMP_HIDDEN, HEAD_DIM), CMP_HIDDEN ** -0.5),
        'cmp_pos_v': nrm(ks[6], (L, CMP_LEN, HEAD_DIM), 0.1),
        'cmp_w1_v': nrm(ks[7], (L, CMP_LEN * HEAD_DIM, CMP_HIDDEN), (CMP_LEN * HEAD_DIM) ** -0.5),
        'cmp_w2_v': nrm(ks[8], (L, CMP_HIDDEN, HEAD_DIM), CMP_HIDDEN ** -0.5),
        'w_out': nrm(ks[9], (L, MIX_WIDTH, D_MODEL), MIX_WIDTH ** -0.5 * BETA),
        'ln1_g': 1.0 + nrm(ks[10], (L, D_MODEL), 0.01),
        'ln1_b': nrm(ks[11], (L, D_MODEL), 0.01),
        'w_router': nrm(ks[12], (L, D_MODEL, N_EXPERTS), D_MODEL ** -0.5),
        'b_router': nrm(ks[13], (L, N_EXPERTS), 0.01),
        'w_gate': nrm(ks[14], (L, N_EXPERTS, D_MODEL, EXPERT_DIM), D_MODEL ** -0.5),
        'w_up': nrm(ks[15], (L, N_EXPERTS, D_MODEL, EXPERT_DIM), D_MODEL ** -0.5),
        'w_down': nrm(ks[16], (L, N_EXPERTS, EXPERT_DIM, D_MODEL), EXPERT_DIM ** -0.5 * BETA),
        'ws_gate': nrm(ks[17], (L, D_MODEL, SHARED_DIM), D_MODEL ** -0.5),
        'ws_up': nrm(ks[18], (L, D_MODEL, SHARED_DIM), D_MODEL ** -0.5),
        'ws_down': nrm(ks[19], (L, SHARED_DIM, D_MODEL), SHARED_DIM ** -0.5 * BETA),
        'ln2_g': 1.0 + nrm(ks[20], (L, D_MODEL), 0.01),
        'ln2_b': nrm(ks[21], (L, D_MODEL), 0.01),
    }


def reference(x, w_in, fox_forget_bias, cmp_pos_k, cmp_w1_k, cmp_w2_k, cmp_pos_v, cmp_w1_v,
              cmp_w2_v, w_out, ln1_g, ln1_b, w_router, b_router, w_gate, w_up, w_down,
              ws_gate, ws_up, ws_down, ln2_g, ln2_b):
    for l in range(DEPTH):
        mix = _token_mixer(x, w_in[l], fox_forget_bias[l], cmp_pos_k[l], cmp_w1_k[l], cmp_w2_k[l],
                           cmp_pos_v[l], cmp_w1_v[l], cmp_w2_v[l], w_out[l])
        x = _layer_norm(ALPHA * x + mix, ln1_g[l], ln1_b[l])
        ffn = _moe(x, w_router[l], b_router[l], w_gate[l], w_up[l], w_down[l],
                   ws_gate[l], ws_up[l], ws_down[l])
        x = _layer_norm(ALPHA * x + ffn, ln2_g[l], ln2_b[l])
    return x
```

```cpp
#include <hip/hip_runtime.h>
#include <hip/hip_cooperative_groups.h>
#include <cstdio>
#include <cstdint>
namespace cg = cooperative_groups;

#ifndef MEGA
#define MEGA 1
#endif
#define PROBE_DUP -1
#define PROBE_SUB 0

typedef __attribute__((ext_vector_type(8))) __bf16 bf8;
typedef __attribute__((ext_vector_type(4))) __bf16 bf4;
typedef __attribute__((ext_vector_type(4))) float f32x4;
typedef __attribute__((ext_vector_type(16))) float f32x16;
typedef unsigned short u16;
typedef unsigned long long u64;

#define DEVI __device__ __forceinline__

constexpr int B_ = 8, T_ = 2048, DM = 1024, NTOK = B_ * T_, NL = 4;
constexpr int NIN = 2778, NPAD = 2816, NCH = 44;
constexpr int NE = 64, EH = 256;
constexpr float ALPHA = 1.681792830507429f;
constexpr float LOG2E = 1.4426950408889634f;
constexpr float QSCALE = 0.125f * LOG2E;
constexpr float LN_EPS = 1e-5f;

constexpr int CH_FOXQ = 0, CH_FOXK = 4, CH_FOXV = 8, CH_NSAQ = 12, CH_NSAKC = 18, CH_NSAVC = 20, CH_NSAKS = 22,
              CH_NSAVS = 24, CH_NSAKW = 26, CH_NSAVW = 28, CH_DSAQ = 30, CH_DSAK = 36, CH_DSAV = 37, CH_IDXQ = 38,
              CH_IDXK = 42, CH_MISC = 43;
constexpr size_t CHSZ = (size_t)B_ * T_ * 64;

constexpr size_t al256(size_t x) { return (x + 255) & ~(size_t)255; }
constexpr size_t OFF_WIN = 0;
constexpr size_t OFF_WO = OFF_WIN + al256((size_t)NL * NPAD * DM * 2);
constexpr size_t OFF_WC1 = OFF_WO + al256((size_t)NL * DM * DM * 2);
constexpr size_t OFF_CB = OFF_WC1 + al256((size_t)NL * 2 * 128 * 2048 * 2);
constexpr size_t OFF_ROPE = OFF_CB + al256((size_t)NL * 2 * 128 * 4);
constexpr size_t OFF_WGU = OFF_ROPE + al256((size_t)T_ * 32 * 8);
constexpr size_t OFF_WD = OFF_WGU + al256((size_t)65 * 512 * DM * 2);
constexpr size_t OFF_XB = OFF_WD + al256((size_t)65 * DM * EH * 2);
constexpr size_t OFF_XA = OFF_XB + al256((size_t)NTOK * DM * 2);
constexpr size_t OFF_XBUF = OFF_XA + al256((size_t)NTOK * DM * 4);
constexpr size_t OFF_O = OFF_XBUF + al256((size_t)NTOK * DM * 4);
constexpr size_t OFF_CNT = OFF_O + al256((size_t)NTOK * DM * 2);
constexpr size_t OFF_LIST = OFF_CNT + al256((size_t)NL * 128 * 4);
constexpr size_t OFF_PAIRW = OFF_LIST + al256((size_t)NE * NTOK * 4);
constexpr size_t OFF_LISTW = OFF_PAIRW + al256((size_t)NTOK * 8 * 4);
constexpr size_t OFF_XL = OFF_LISTW + al256((size_t)NE * NTOK * 4);
constexpr size_t OFF_WR2 = OFF_XL + al256((size_t)NTOK * DM * 2);
constexpr size_t OFF_CBP = OFF_WR2 + al256((size_t)NL * 128 * 2048 * 2);
constexpr size_t OFF_BAR = OFF_CBP + al256((size_t)NL * 2 * 8 * 128 * 4);
constexpr size_t BAR_BYTES = 16384;
constexpr size_t OFF_SCR = OFF_BAR + BAR_BYTES;
constexpr size_t OFF_CH = OFF_SCR;
constexpr size_t OFF_MISC = OFF_CH + al256((size_t)43 * CHSZ * 2);
constexpr size_t OFF_CL = OFF_MISC + al256((size_t)NTOK * 32 * 4);
constexpr size_t OFF_KCMP = OFF_CL + al256((size_t)B_ * 4 * T_ * 4);
constexpr size_t OFF_VCMPT = OFF_KCMP + al256((size_t)B_ * 2 * 128 * 64 * 2);
constexpr size_t OFF_OCMP = OFF_VCMPT + al256((size_t)B_ * 2 * 64 * 128 * 2);
constexpr size_t OFF_SELM = OFF_OCMP + al256((size_t)NTOK * 384 * 4);
constexpr size_t OFF_DMASK = OFF_SELM + al256((size_t)B_ * 2 * T_ * 4);
constexpr size_t OFF_DSCR = OFF_DMASK + al256((size_t)NTOK * 32 * 8);
constexpr int MAXGRID = 768;
constexpr size_t ATT_END = OFF_DSCR + (size_t)MAXGRID * 32 * 2048 * 4;
constexpr size_t OFF_H = OFF_SCR;
constexpr size_t OFF_Y = OFF_H + al256((size_t)(NTOK * 9 + 256) * EH * 2);
constexpr size_t OFF_YSH = OFF_Y + al256((size_t)NTOK * 8 * DM * 2);
constexpr size_t MOE_END = OFF_YSH + al256((size_t)NTOK * DM * 2);
constexpr size_t WS_NEED = ATT_END > MOE_END ? ATT_END : MOE_END;

struct Params {
  const float* in[22];
  float* out;
  char* ws;
};

DEVI int get_tid() { int t = threadIdx.x; asm volatile("" : "+v"(t)); return t; }
DEVI float bf2f(u16 v) { return __uint_as_float(((unsigned)v) << 16); }
DEVI u16 f2bf(float f) { __bf16 b = (__bf16)f; return __builtin_bit_cast(u16, b); }
DEVI unsigned pk2(float a, float b) { return (unsigned)f2bf(a) | ((unsigned)f2bf(b) << 16); }
DEVI uint2 pk4(float a, float b, float c, float d) { return make_uint2(pk2(a, b), pk2(c, d)); }
DEVI float fexp2(float x) { return __builtin_amdgcn_exp2f(x); }
DEVI float sigmoidf_(float x) { return 1.f / (1.f + __expf(-x)); }
DEVI float wave_sum(float v) {
#pragma unroll
  for (int o = 32; o > 0; o >>= 1) v += __shfl_xor(v, o);
  return v;
}
DEVI void glds16(const void* g, void* l) {
  __builtin_amdgcn_global_load_lds((const unsigned*)g, (unsigned*)l, 16, 0, 0);
}
DEVI void wait_vm0() { asm volatile("s_waitcnt vmcnt(0)" ::: "memory"); }
DEVI float ld_sc1(const float* p) { return __hip_atomic_load(p, __ATOMIC_RELAXED, __HIP_MEMORY_SCOPE_AGENT); }

#define XB_TMO      128
#define XB_XCNT(j)  (256  + 64 * (j))
#define XB_XSUB(j)  (1280 + 64 * (j))
#define XB_XGEN(j)  (2304 + 64 * (j))
#define XB_TOP      3328
#define XB_TOPGEN   3392
#define XB_WCTR     3456
#define XB_SPIN_CAP (1u << 22)
#define LAS __attribute__((address_space(3)))
DEVI unsigned xb_ld(unsigned* p) { return __hip_atomic_load(p, __ATOMIC_RELAXED, __HIP_MEMORY_SCOPE_AGENT); }
DEVI unsigned xb_add(unsigned* p, unsigned v) { return __hip_atomic_fetch_add(p, v, __ATOMIC_RELAXED, __HIP_MEMORY_SCOPE_AGENT); }
DEVI unsigned xb_xcc_id() { return (unsigned)__builtin_amdgcn_s_getreg((3 << 11) | 20) & 0xFu; }
#define XB_SPIN(cond, bar) do { unsigned _sp = 0; while (cond) { __builtin_amdgcn_s_sleep(1); \
    if ((++_sp & 255u) == 0u) { if (xb_ld(&(bar)[XB_TMO])) break; if (_sp > XB_SPIN_CAP) { atomicAdd(&(bar)[XB_TMO], 1u); break; } } } } while (0)
struct XcdBarrier { unsigned* bar; unsigned x; volatile LAS unsigned* st; };
DEVI XcdBarrier xcd_barrier_post(unsigned* bar, volatile LAS unsigned* st) {
  XcdBarrier b; b.bar = bar; b.x = xb_xcc_id(); b.st = st;
  if (threadIdx.x == 0) (void)xb_add(&bar[XB_XCNT(b.x)], 1u);
  return b;
}
DEVI void xcd_barrier_complete(unsigned* bar, unsigned x, unsigned& nloc, unsigned& nx) {
  const unsigned G = gridDim.x * gridDim.y * gridDim.z;
  unsigned sum, cnt, mine, sp = 0u;
  for (;;) {
    sum = 0u; cnt = 0u; mine = 0u;
#pragma unroll
    for (unsigned j = 0; j < 16; ++j) { const unsigned c = xb_ld(&bar[XB_XCNT(j)]); sum += c; cnt += (c > 0u) ? 1u : 0u; mine = (j == x) ? c : mine; }
    if (sum == G) break;
    __builtin_amdgcn_s_sleep(1);
    if ((++sp & 255u) == 0u) { if (xb_ld(&bar[XB_TMO])) break; if (sp > XB_SPIN_CAP) { atomicAdd(&bar[XB_TMO], 1u); break; } }
  }
  nloc = mine > 0u ? mine : 1u; nx = cnt > 0u ? cnt : 1u;
}
DEVI void xcd_barrier(const XcdBarrier& b) {
  asm volatile("s_waitcnt vmcnt(0)" ::: "memory");
  __syncthreads();
  if (threadIdx.x == 0) {
    unsigned* bar = b.bar;
    asm volatile("" : "+s"(bar));
    __builtin_amdgcn_s_waitcnt(0);
    unsigned nloc = b.st[0], nx = b.st[1];
    if (nloc == 0u) { xcd_barrier_complete(bar, b.x, nloc, nx); b.st[0] = nloc; b.st[1] = nx; }
    const unsigned old = xb_add(&bar[XB_XSUB(b.x)], 1u);
    const unsigned gen = old / nloc;
    if (old + 1u == (gen + 1u) * nloc) {
      __builtin_amdgcn_fence(__ATOMIC_RELEASE, "agent");
      asm volatile("s_waitcnt vmcnt(0)" ::: "memory");
      const unsigned og = xb_add(&bar[XB_TOP], 1u);
      const unsigned tg = og / nx;
      if (og + 1u == (tg + 1u) * nx) xb_add(&bar[XB_TOPGEN], 1u);
      else XB_SPIN(xb_ld(&bar[XB_TOPGEN]) == tg, bar);
      __builtin_amdgcn_fence(__ATOMIC_ACQUIRE, "agent");
      xb_add(&bar[XB_XGEN(b.x)], 1u);
      asm volatile("s_waitcnt vmcnt(0)" ::: "memory");
    } else {
      XB_SPIN(xb_ld(&bar[XB_XGEN(b.x)]) == gen, bar);
      __builtin_amdgcn_fence(__ATOMIC_ACQUIRE, "agent");
      asm volatile("s_waitcnt vmcnt(0)" ::: "memory");
    }
  }
  __syncthreads();
}
DEVI int next_item(unsigned* ctr, char* smem) {
  volatile int* slot = (volatile int*)(smem + 66560);
  __syncthreads();
  if (threadIdx.x == 0) *slot = (int)xb_add(ctr, 1u);
  __syncthreads();
  return *slot;
}

DEVI void gemm128(const u16* __restrict__ A, const long (&aoff)[4], const u16* __restrict__ Bt, long ldb, int n0,
                  int K, char* smem, f32x4 (&acc)[4][4], int ksplit = 1 << 30, long kjump = 0) {
  const int tid = get_tid(), lane = tid & 63, wid = tid >> 6, wr = wid >> 1, wc = wid & 1;
#pragma unroll
  for (int m = 0; m < 4; ++m)
#pragma unroll
    for (int n = 0; n < 4; ++n) acc[m][n] = (f32x4){0.f, 0.f, 0.f, 0.f};
  const int srow = tid >> 3, scp = tid & 7;
  long boff[4];
  int sc[4];
#pragma unroll
  for (int i = 0; i < 4; ++i) {
    const int row = srow + 32 * i;
    sc[i] = (scp ^ ((row >> 1) & 7)) * 8;
    boff[i] = (long)(n0 + row) * ldb;
  }
  const int sw = (lane >> 1) & 7;
  __syncthreads();
#pragma unroll
  for (int i = 0; i < 4; ++i) {
    glds16(A + aoff[i] + sc[i], smem + tid * 16 + i * 4096);
    glds16(Bt + boff[i] + sc[i], smem + 16384 + tid * 16 + i * 4096);
  }
  int cur = 0;
  for (int kt = 0; kt < K; kt += 64) {
    wait_vm0();
    __syncthreads();
    char* SA = smem + cur * 32768;
    char* SB = SA + 16384;
    if (kt + 64 < K) {
      char* NA = smem + (cur ^ 1) * 32768;
#pragma unroll
      for (int i = 0; i < 4; ++i) {
        glds16(A + aoff[i] + kt + 64 + ((kt + 64 >= ksplit) ? kjump : 0) + sc[i], NA + tid * 16 + i * 4096);
        glds16(Bt + boff[i] + kt + 64 + sc[i], NA + 16384 + tid * 16 + i * 4096);
      }
    }
#pragma unroll
    for (int ks = 0; ks < 2; ++ks) {
      bf8 af[4], bfr[4];
      const int c = ((ks * 4 + (lane >> 4)) ^ sw) << 4;
#pragma unroll
      for (int m = 0; m < 4; ++m) af[m] = *(const bf8*)(SA + (wr * 64 + m * 16 + (lane & 15)) * 128 + c);
#pragma unroll
      for (int n = 0; n < 4; ++n) bfr[n] = *(const bf8*)(SB + (wc * 64 + n * 16 + (lane & 15)) * 128 + c);
      __builtin_amdgcn_s_setprio(1);
#pragma unroll
      for (int m = 0; m < 4; ++m)
#pragma unroll
        for (int n = 0; n < 4; ++n) acc[m][n] = __builtin_amdgcn_mfma_f32_16x16x32_bf16(bfr[n], af[m], acc[m][n], 0, 0, 0);
      __builtin_amdgcn_s_setprio(0);
    }
    cur ^= 1;
  }
}

template <int EPI_ST, class Epi>
DEVI void gemm128_stream(const u16* __restrict__ A, const long (&aoff)[4], const u16* __restrict__ Bt, long ldb, int n0,
                         int ntiles, int K, char* smem, Epi epi) {
  const int tid = get_tid(), lane = tid & 63, wid = tid >> 6, wr = wid >> 1, wc = wid & 1;
  f32x4 acc[4][4];
#pragma unroll
  for (int m = 0; m < 4; ++m)
#pragma unroll
    for (int n = 0; n < 4; ++n) acc[m][n] = (f32x4){0.f, 0.f, 0.f, 0.f};
  const int srow = tid >> 3, scp = tid & 7;
  long boff[4];
  int sc[4];
#pragma unroll
  for (int i = 0; i < 4; ++i) {
    const int row = srow + 32 * i;
    sc[i] = (scp ^ ((row >> 1) & 7)) * 8;
    boff[i] = (long)(n0 + row) * ldb;
  }
  const int sw = (lane >> 1) & 7;
  const int ksteps = K >> 6, total = ntiles * ksteps;
  __syncthreads();
#pragma unroll
  for (int i = 0; i < 4; ++i) {
    glds16(A + aoff[i] + sc[i], smem + tid * 16 + i * 4096);
    glds16(Bt + boff[i] + sc[i], smem + 16384 + tid * 16 + i * 4096);
  }
  int cur = 0, ks = 0, tile = 0;
  bool after_epi = false;
  for (int st = 0; st < total; ++st) {
    if (EPI_ST > 0 && after_epi) {
      asm volatile("s_waitcnt vmcnt(%0)" ::"n"(EPI_ST) : "memory");
      asm volatile("s_waitcnt lgkmcnt(0)" ::: "memory");
      __builtin_amdgcn_s_barrier();
    } else {
      wait_vm0();
      __syncthreads();
    }
    after_epi = false;
    char* SA = smem + cur * 32768;
    char* SB = SA + 16384;
    if (st + 1 < total) {
      int nks = ks + 1, ntile = tile;
      if (nks == ksteps) { nks = 0; ++ntile; }
      char* NA = smem + (cur ^ 1) * 32768;
      const long bo = (long)ntile * 128 * ldb + nks * 64;
#pragma unroll
      for (int i = 0; i < 4; ++i) {
        glds16(A + aoff[i] + nks * 64 + sc[i], NA + tid * 16 + i * 4096);
        glds16(Bt + boff[i] + bo + sc[i], NA + 16384 + tid * 16 + i * 4096);
      }
    }
#pragma unroll
    for (int k2 = 0; k2 < 2; ++k2) {
      bf8 af[4], bfr[4];
      const int c = ((k2 * 4 + (lane >> 4)) ^ sw) << 4;
#pragma unroll
      for (int m = 0; m < 4; ++m) af[m] = *(const bf8*)(SA + (wr * 64 + m * 16 + (lane & 15)) * 128 + c);
#pragma unroll
      for (int n = 0; n < 4; ++n) bfr[n] = *(const bf8*)(SB + (wc * 64 + n * 16 + (lane & 15)) * 128 + c);
      __builtin_amdgcn_s_setprio(1);
#pragma unroll
      for (int m = 0; m < 4; ++m)
#pragma unroll
        for (int n = 0; n < 4; ++n) acc[m][n] = __builtin_amdgcn_mfma_f32_16x16x32_bf16(bfr[n], af[m], acc[m][n], 0, 0, 0);
      __builtin_amdgcn_s_setprio(0);
    }
    cur ^= 1;
    if (++ks == ksteps) {
      after_epi = epi(tile, acc);
#pragma unroll
      for (int m = 0; m < 4; ++m)
#pragma unroll
        for (int n = 0; n < 4; ++n) acc[m][n] = (f32x4){0.f, 0.f, 0.f, 0.f};
      ks = 0;
      ++tile;
    }
  }
}

typedef unsigned char u8;
constexpr float F8_SW = 32.f;
constexpr float F8_SH = 4.f;
DEVI unsigned pk4_f8(float a, float b, float c, float d) {
  int w = 0;
  w = __builtin_amdgcn_cvt_pk_fp8_f32(a, b, w, false);
  w = __builtin_amdgcn_cvt_pk_fp8_f32(c, d, w, true);
  return (unsigned)w;
}
DEVI unsigned pk4_f8c(float a, float b, float c, float d) {
  return pk4_f8(__builtin_amdgcn_fmed3f(a, -448.f, 448.f), __builtin_amdgcn_fmed3f(b, -448.f, 448.f),
                __builtin_amdgcn_fmed3f(c, -448.f, 448.f), __builtin_amdgcn_fmed3f(d, -448.f, 448.f));
}
DEVI void gemm128_f8(const u8* __restrict__ A, const long (&aoff)[4], const u8* __restrict__ Bt, long ldb, int n0,
                     int K, char* smem, f32x4 (&acc)[4][4]) {
  const int tid = get_tid(), lane = tid & 63, wid = tid >> 6, wr = wid >> 1, wc = wid & 1;
#pragma unroll
  for (int m = 0; m < 4; ++m)
#pragma unroll
    for (int n = 0; n < 4; ++n) acc[m][n] = (f32x4){0.f, 0.f, 0.f, 0.f};
  const int srow = tid >> 3, scp = tid & 7;
  long boff[4];
  int sc[4];
#pragma unroll
  for (int i = 0; i < 4; ++i) {
    const int row = srow + 32 * i;
    sc[i] = (scp ^ ((row >> 1) & 7)) * 16;
    boff[i] = (long)(n0 + row) * ldb;
  }
  const int sw = (lane >> 1) & 7, g = lane >> 4;
  __syncthreads();
#pragma unroll
  for (int i = 0; i < 4; ++i) {
    glds16(A + aoff[i] + sc[i], smem + tid * 16 + i * 4096);
    glds16(Bt + boff[i] + sc[i], smem + 16384 + tid * 16 + i * 4096);
  }
  int cur = 0;
  for (int kt = 0; kt < K; kt += 128) {
    wait_vm0();
    __syncthreads();
    char* SA = smem + cur * 32768;
    char* SB = SA + 16384;
    if (kt + 128 < K) {
      char* NA = smem + (cur ^ 1) * 32768;
#pragma unroll
      for (int i = 0; i < 4; ++i) {
        glds16(A + aoff[i] + kt + 128 + sc[i], NA + tid * 16 + i * 4096);
        glds16(Bt + boff[i] + kt + 128 + sc[i], NA + 16384 + tid * 16 + i * 4096);
      }
    }
#pragma unroll
    for (int ks = 0; ks < 4; ++ks) {
      long af[4], bfr[4];
      const int c = (((2 * ks + (g >> 1)) ^ sw) << 4) + 8 * (g & 1);
#pragma unroll
      for (int m = 0; m < 4; ++m) af[m] = *(const long*)(SA + (wr * 64 + m * 16 + (lane & 15)) * 128 + c);
#pragma unroll
      for (int n = 0; n < 4; ++n) bfr[n] = *(const long*)(SB + (wc * 64 + n * 16 + (lane & 15)) * 128 + c);
      __builtin_amdgcn_s_setprio(1);
#pragma unroll
      for (int m = 0; m < 4; ++m)
#pragma unroll
        for (int n = 0; n < 4; ++n) acc[m][n] = __builtin_amdgcn_mfma_f32_16x16x32_fp8_fp8(bfr[n], af[m], acc[m][n], 0, 0, 0);
      __builtin_amdgcn_s_setprio(0);
    }
    cur ^= 1;
  }
}

template <int EPI_ST, class Epi>
DEVI void gemm128_stream_f8(const u8* __restrict__ A, const long (&aoff)[4], const u8* __restrict__ Bt, long ldb, int n0,
                            int ntiles, int K, char* smem, Epi epi) {
  const int tid = get_tid(), lane = tid & 63, wid = tid >> 6, wr = wid >> 1, wc = wid & 1;
  f32x4 acc[4][4];
#pragma unroll
  for (int m = 0; m < 4; ++m)
#pragma unroll
    for (int n = 0; n < 4; ++n) acc[m][n] = (f32x4){0.f, 0.f, 0.f, 0.f};
  const int srow = tid >> 3, scp = tid & 7;
  long boff[4];
  int sc[4];
#pragma unroll
  for (int i = 0; i < 4; ++i) {
    const int row = srow + 32 * i;
    sc[i] = (scp ^ ((row >> 1) & 7)) * 16;
    boff[i] = (long)(n0 + row) * ldb;
  }
  const int sw = (lane >> 1) & 7, g = lane >> 4;
  const int ksteps = K >> 7, total = ntiles * ksteps;
  __syncthreads();
#pragma unroll
  for (int i = 0; i < 4; ++i) {
    glds16(A + aoff[i] + sc[i], smem + tid * 16 + i * 4096);
    glds16(Bt + boff[i] + sc[i], smem + 16384 + tid * 16 + i * 4096);
  }
  int cur = 0, ks = 0, tile = 0;
  bool after_epi = false;
  for (int st = 0; st < total; ++st) {
    if (EPI_ST > 0 && after_epi) {
      asm volatile("s_waitcnt vmcnt(%0)" ::"n"(EPI_ST) : "memory");
      asm volatile("s_waitcnt lgkmcnt(0)" ::: "memory");
      __builtin_amdgcn_s_barrier();
    } else {
      wait_vm0();
      __syncthreads();
    }
    after_epi = false;
    char* SA = smem + cur * 32768;
    char* SB = SA + 16384;
    if (st + 1 < total) {
      int nks = ks + 1, ntile = tile;
      if (nks == ksteps) { nks = 0; ++ntile; }
      char* NA = smem + (cur ^ 1) * 32768;
      const long bo = (long)ntile * 128 * ldb + nks * 128;
#pragma unroll
      for (int i = 0; i < 4; ++i) {
        glds16(A + aoff[i] + nks * 128 + sc[i], NA + tid * 16 + i * 4096);
        glds16(Bt + boff[i] + bo + sc[i], NA + 16384 + tid * 16 + i * 4096);
      }
    }
#pragma unroll
    for (int k2 = 0; k2 < 4; ++k2) {
      long af[4], bfr[4];
      const int c = (((2 * k2 + (g >> 1)) ^ sw) << 4) + 8 * (g & 1);
#pragma unroll
      for (int m = 0; m < 4; ++m) af[m] = *(const long*)(SA + (wr * 64 + m * 16 + (lane & 15)) * 128 + c);
#pragma unroll
      for (int n = 0; n < 4; ++n) bfr[n] = *(const long*)(SB + (wc * 64 + n * 16 + (lane & 15)) * 128 + c);
      __builtin_amdgcn_s_setprio(1);
#pragma unroll
      for (int m = 0; m < 4; ++m)
#pragma unroll
        for (int n = 0; n < 4; ++n) acc[m][n] = __builtin_amdgcn_mfma_f32_16x16x32_fp8_fp8(bfr[n], af[m], acc[m][n], 0, 0, 0);
      __builtin_amdgcn_s_setprio(0);
    }
    cur ^= 1;
    if (++ks == ksteps) {
      after_epi = epi(tile, acc);
#pragma unroll
      for (int m = 0; m < 4; ++m)
#pragma unroll
        for (int n = 0; n < 4; ++n) acc[m][n] = (f32x4){0.f, 0.f, 0.f, 0.f};
      ks = 0;
      ++tile;
    }
  }
}

template <class CP>
DEVI void cvt_tile(CP colptr, int ld, int k0, u16* __restrict__ dst, int dstK, int nrow0, char* smem) {
  float* tile = (float*)smem;
  const int tid = get_tid(), n = tid & 31, kk = tid >> 5;
  const float* cp = colptr(nrow0 + n);
#pragma unroll
  for (int i = 0; i < 8; ++i) {
    const int k = kk + 8 * i;
    tile[n * 65 + k] = cp ? cp[(long)(k0 + k) * ld] : 0.f;
  }
  __syncthreads();
  const int r = tid >> 3, c8 = (tid & 7) * 8;
  const float* tp = tile + r * 65 + c8;
  uint4 v;
  v.x = pk2(tp[0], tp[1]); v.y = pk2(tp[2], tp[3]); v.z = pk2(tp[4], tp[5]); v.w = pk2(tp[6], tp[7]);
  *(uint4*)(dst + (long)(nrow0 + r) * dstK + k0 + c8) = v;
  __syncthreads();
}

template <class PERM>
DEVI void cvt64(const float* __restrict__ srcA, const float* __restrict__ srcB, int ld, int k0, u16* __restrict__ dst, int dstK,
                int nrow0, PERM perm, char* smem) {
  float* tile = (float*)smem;
  const int tid = get_tid();
  {
    const int c4 = (tid & 15) * 4, kr = tid >> 4;
    const float* sp = c4 < 32 ? srcA + c4 : srcB + (c4 - 32);
#pragma unroll
    for (int i = 0; i < 4; ++i) {
      const int k = kr + 16 * i;
      const float4 v = *(const float4*)(sp + (long)(k0 + k) * ld);
      float* tp = tile + k * 65 + c4;
      tp[0] = v.x; tp[1] = v.y; tp[2] = v.z; tp[3] = v.w;
    }
  }
  __syncthreads();
  {
    const int r = tid >> 2, kc = (tid & 3) * 16;
    const float* tp = tile + kc * 65 + perm(r);
    uint4 v0, v1;
    v0.x = pk2(tp[0], tp[65]); v0.y = pk2(tp[130], tp[195]); v0.z = pk2(tp[260], tp[325]); v0.w = pk2(tp[390], tp[455]);
    v1.x = pk2(tp[520], tp[585]); v1.y = pk2(tp[650], tp[715]); v1.z = pk2(tp[780], tp[845]); v1.w = pk2(tp[910], tp[975]);
    u16* dp = dst + (long)(nrow0 + r) * dstK + k0 + kc;
    *(uint4*)dp = v0;
    *(uint4*)(dp + 8) = v1;
  }
  __syncthreads();
}
DEVI int perm16(int c) { return 16 * ((c >> 2) & 3) + 4 * (c >> 4) + (c & 3); }
struct CvtJob { const float* sp; long rstride; u8* dp; int permflag; };
DEVI void cvt64_load(const CvtJob& j, float4 (&v)[4]) {
#pragma unroll
  for (int i = 0; i < 4; ++i) v[i] = *(const float4*)(j.sp + (long)(16 * i) * j.rstride);
}
DEVI void lds_barrier() {
  asm volatile("s_waitcnt lgkmcnt(0)" ::: "memory");
  __builtin_amdgcn_s_barrier();
}
DEVI void cvt64_store(const CvtJob& j, const float4 (&v)[4], char* smem) {
  float* tile = (float*)smem;
  const int tid = get_tid();
  {
    const int c4 = (tid & 15) * 4, kr = tid >> 4;
#pragma unroll
    for (int i = 0; i < 4; ++i) {
      float* tp = tile + (kr + 16 * i) * 65 + c4;
      tp[0] = v[i].x; tp[1] = v[i].y; tp[2] = v[i].z; tp[3] = v[i].w;
    }
  }
  lds_barrier();
  {
    const int r = tid >> 2, kc = (tid & 3) * 16;
    const float* tp = tile + kc * 65 + (j.permflag ? perm16(r) : r);
    uint4 v0;
    v0.x = pk4_f8(tp[0] * F8_SW, tp[65] * F8_SW, tp[130] * F8_SW, tp[195] * F8_SW);
    v0.y = pk4_f8(tp[260] * F8_SW, tp[325] * F8_SW, tp[390] * F8_SW, tp[455] * F8_SW);
    v0.z = pk4_f8(tp[520] * F8_SW, tp[585] * F8_SW, tp[650] * F8_SW, tp[715] * F8_SW);
    v0.w = pk4_f8(tp[780] * F8_SW, tp[845] * F8_SW, tp[910] * F8_SW, tp[975] * F8_SW);
    *(uint4*)j.dp = v0;
  }
  lds_barrier();
}
DEVI CvtJob cvt64_job(const float* srcA, const float* srcB, int ld, int k0, u8* dst, int dstK, int nrow0, int permflag, int tid) {
  CvtJob j;
  const int c4 = (tid & 15) * 4, kr = tid >> 4;
  j.sp = (c4 < 32 ? srcA + c4 : srcB + (c4 - 32)) + (long)(k0 + kr) * ld;
  j.rstride = ld;
  j.dp = dst + (long)(nrow0 + (tid >> 2)) * dstK + k0 + (tid & 3) * 16;
  j.permflag = permflag;
  return j;
}

DEVI int win_srccol(int np) {
  const int j = np >> 6, d = np & 63;
  if (j < 12) return 64 * j + d;
  if (j < 30) return 772 + 64 * (j - 12) + d;
  if (j < 43) return 1942 + 64 * (j - 30) + d;
  if (d < 4) return 768 + d;
  if (d < 22) return 1924 + (d - 4);
  if (d < 26) return 2774 + (d - 22);
  return -1;
}

DEVI void phase_prep(const Params& p, char* smem) {
  const int tid = get_tid();
  u16* WIN = (u16*)(p.ws + OFF_WIN);
  u16* WO = (u16*)(p.ws + OFF_WO);
  u16* WC1 = (u16*)(p.ws + OFF_WC1);
  float2* ROPE = (float2*)(p.ws + OFF_ROPE);
  u16* XB = (u16*)(p.ws + OFF_XB);
  unsigned* CNT = (unsigned*)(p.ws + OFF_CNT);
  constexpr int N_WIN = NL * 88 * 16, N_WO = NL * 16 * 16, N_WC1 = NL * 2 * 4 * 32, N_CB = NL * 2 * 8, N_ROPE = 256,
                N_XB = NTOK * DM / 4096, N_WR = NL * 128, N_Z = 1;
  constexpr int TOT = N_WIN + N_WO + N_WC1 + N_CB + N_ROPE + N_XB + N_WR + N_Z;
  u16* WR2 = (u16*)(p.ws + OFF_WR2);
  float* CBP = (float*)(p.ws + OFF_CBP);
  for (int it = blockIdx.x; it < TOT; it += gridDim.x) {
    int i = it;
    if (i < N_WIN) {
      const int l = i / (88 * 16), r = i % (88 * 16), grp = r / 16, kt = r % 16;
      const float* src = p.in[1] + (size_t)l * DM * NIN;
      cvt_tile([&](int np) -> const float* { int c = win_srccol(np); return c >= 0 ? src + c : nullptr; }, NIN, kt * 64,
               WIN + (size_t)l * NPAD * DM, DM, grp * 32, smem);
      continue;
    }
    i -= N_WIN;
    if (i < N_WO) {
      const int l = i / 256, r = i % 256, grp = r / 16, kt = r % 16;
      const float* src = p.in[9] + (size_t)l * DM * DM + grp * 64;
      cvt64(src, src + 32, DM, kt * 64, WO + (size_t)l * DM * DM, DM, grp * 64, [](int r) { return perm16(r); }, smem);
      continue;
    }
    i -= N_WO;
    if (i < N_WC1) {
      const int lk = i / 128, r = i % 128, grp = r / 32, kt = r % 32;
      const int l = lk >> 1, kv = lk & 1;
      const float* src = p.in[kv ? 7 : 4] + (size_t)l * 2048 * 128;
      cvt_tile([&](int np) -> const float* { return src + np; }, 128, kt * 64, WC1 + (size_t)lk * 128 * 2048, 2048, grp * 32, smem);
      continue;
    }
    i -= N_WC1;
    if (i < N_CB) {
      const int lk = i >> 3, ch = i & 7, l = lk >> 1, kv = lk & 1;
      const float* pe = p.in[kv ? 6 : 3] + (size_t)l * 2048 + ch * 256;
      const float* w1 = p.in[kv ? 7 : 4] + (size_t)l * 2048 * 128 + (size_t)ch * 256 * 128;
      const int j = tid & 127, half = tid >> 7;
      float a = 0.f;
#pragma unroll 16
      for (int k = half * 128; k < half * 128 + 128; ++k) a += pe[k] * w1[(size_t)k * 128 + j];
      float* red = (float*)smem;
      if (half) red[j] = a;
      __syncthreads();
      if (!half) CBP[(size_t)i * 128 + j] = a + red[j];
      __syncthreads();
      continue;
    }
    i -= N_CB;
    if (i < N_ROPE) {
      const int idx = i * 256 + tid;
      const int t = idx >> 5, f = idx & 31;
      const double inv = pow(10000.0, -(double)f / 32.0);
      const double ang = (double)t * inv;
      ROPE[idx] = make_float2((float)cos(ang), (float)sin(ang));
      continue;
    }
    i -= N_ROPE;
    if (i < N_XB) {
      const float* x = p.in[0] + (size_t)i * 4096;
      u16* d = XB + (size_t)i * 4096;
#pragma unroll
      for (int j = 0; j < 4; ++j) {
        const int e = (j * 256 + tid) * 4;
        const float4 v = *(const float4*)(x + e);
        *(uint2*)(d + e) = pk4(v.x, v.y, v.z, v.w);
      }
      continue;
    }
    i -= N_XB;
    if (i < N_WR) {
      const int l = i >> 7, r = i & 127, wcs = r >> 6, within = r & 63, e = wcs * 32 + (within & 31);
      const float* wsrc = p.in[12] + (size_t)l * DM * NE + e;
      u16* d = WR2 + ((size_t)l * 128 + r) * 2048;
#pragma unroll
      for (int q = 0; q < 4; ++q) {
        const int k = tid + 256 * q;
        const float wv = wsrc[(size_t)k * NE];
        const u16 hi = f2bf(wv);
        const u16 lo = f2bf(wv - bf2f(hi));
        d[k] = within < 32 ? hi : lo;
        d[1024 + k] = within < 32 ? hi : (u16)0;
      }
      continue;
    }
    i -= N_WR;
    { for (int j = tid; j < NL * 128; j += 256) CNT[j] = 0u; }
  }
}

#define XCD_LOOP(it, n)                                                            \
  for (int it = ((blockIdx.x & 7) * (((n) + 7) >> 3)) + (blockIdx.x >> 3),         \
           it##_end = min((int)(n), ((blockIdx.x & 7) + 1) * (((n) + 7) >> 3));   \
       it < it##_end; it += (gridDim.x >> 3))

DEVI void inproj_epilogue(const Params& p, f32x4 (&acc)[4][4], int m0, int n0) {
  const int tid = get_tid(), lane = tid & 63, wid = tid >> 6, wr = wid >> 1, wc = wid & 1;
  const int j = (n0 >> 6) + wc;
  const float2* ROPE = (const float2*)(p.ws + OFF_ROPE);
  u16* CH = (u16*)(p.ws + OFF_CH);
  float* MISC = (float*)(p.ws + OFF_MISC);
  const bool rope = (j >= 12 && j <= 19) || j == 22 || j == 23 || j == 26 || j == 27 || (j >= 30 && j <= 36) ||
                    (j >= 38 && j <= 42);
  const bool qs = (j < 4) || (j >= 12 && j <= 17) || (j >= 30 && j <= 35);
  const bool tr = (j >= 8 && j <= 11) || j == 24 || j == 25 || j == 28 || j == 29 || j == 37;
  const float scl = qs ? QSCALE : 1.f;
  const int dq = 4 * (lane >> 4);
#pragma unroll
  for (int m = 0; m < 4; ++m) {
    const int tok = m0 + wr * 64 + m * 16 + (lane & 15);
    const int b = tok >> 11, t = tok & 2047;
    if (j == CH_MISC) {
#pragma unroll
      for (int n = 0; n < 2; ++n) *(f32x4*)(MISC + (size_t)tok * 32 + n * 16 + dq) = acc[m][n];
      continue;
    }
    float y[4][4];
#pragma unroll
    for (int n = 0; n < 2; ++n) {
#pragma unroll
      for (int q = 0; q < 4; ++q) {
        const int d = n * 16 + dq + q;
        float x1 = acc[m][n][q], x2 = acc[m][n + 2][q];
        if (rope) {
          const float2 cs = ROPE[t * 32 + d];
          const float y1 = x1 * cs.x - x2 * cs.y, y2 = x2 * cs.x + x1 * cs.y;
          x1 = y1; x2 = y2;
        }
        y[n][q] = x1 * scl;
        y[n + 2][q] = x2 * scl;
      }
    }
    if (!tr) {
      u16* o = CH + (size_t)j * CHSZ + (size_t)tok * 64;
#pragma unroll
      for (int n = 0; n < 4; ++n) *(uint2*)(o + n * 16 + dq) = pk4(y[n][0], y[n][1], y[n][2], y[n][3]);
    } else {
      u16* o = CH + (size_t)j * CHSZ + (size_t)b * 64 * T_ + t;
#pragma unroll
      for (int n = 0; n < 4; ++n)
#pragma unroll
        for (int q = 0; q < 4; ++q) o[(size_t)(n * 16 + dq + q) * T_] = f2bf(y[n][q]);
    }
  }
}

DEVI void phase_inproj(const Params& p, int l, char* smem) {
  const int tid = get_tid();
  const u16* XB = (const u16*)(p.ws + OFF_XB);
  const u16* WIN = (const u16*)(p.ws + OFF_WIN) + (size_t)l * NPAD * DM;
  u8* WGU = (u8*)(p.ws + OFF_WGU);
  u8* WD = (u8*)(p.ws + OFF_WD);
  constexpr int N_G = 128 * 22, N_GU = 65 * 8 * 16, N_D = 65 * 16 * 4, N_C = N_GU + N_D;
  XCD_LOOP(it, N_G) {
    {
      const int mt = it / 22, nt = it % 22;
      long aoff[4];
#pragma unroll
      for (int q = 0; q < 4; ++q) aoff[q] = (long)(mt * 128 + (tid >> 3) + 32 * q) * DM;
      f32x4 acc[4][4];
      gemm128(XB, aoff, WIN, DM, nt * 128, DM, smem, acc);
      inproj_epilogue(p, acc, mt * 128, nt * 128);
    }
    __syncthreads();
    const int c0 = (int)((long)it * N_C / N_G), c1 = (int)((long)(it + 1) * N_C / N_G);
    auto make_job = [&](int i) -> CvtJob {
      if (i < N_GU) {
        const int e = i / 128, r = i % 128, grp = r / 16, kt = r % 16;
        const float* sg = (e < 64) ? p.in[14] + ((size_t)l * 64 + e) * DM * EH : p.in[17] + (size_t)l * DM * EH;
        const float* su = (e < 64) ? p.in[15] + ((size_t)l * 64 + e) * DM * EH : p.in[18] + (size_t)l * DM * EH;
        return cvt64_job(sg + grp * 32, su + grp * 32, EH, kt * 64, WGU + (size_t)e * 512 * DM, DM, grp * 64, 0, tid);
      } else {
        const int i2 = i - N_GU;
        const int e = i2 / 64, r = i2 % 64, grp = r / 4, kt = r % 4;
        const float* src = ((e < 64) ? p.in[16] + ((size_t)l * 64 + e) * EH * DM : p.in[19] + (size_t)l * EH * DM) + grp * 64;
        return cvt64_job(src, src + 32, DM, kt * 64, WD + (size_t)e * DM * EH, EH, grp * 64, 1, tid);
      }
    };
    if (c0 < c1) {
      CvtJob job = make_job(c0);
      float4 cur[4], nxt[4];
      cvt64_load(job, cur);
      for (int i = c0; i < c1; ++i) {
        CvtJob njob = job;
        if (i + 1 < c1) { njob = make_job(i + 1); cvt64_load(njob, nxt); }
        cvt64_store(job, cur, smem);
        job = njob;
#pragma unroll
        for (int q = 0; q < 4; ++q) cur[q] = nxt[q];
      }
      __syncthreads();
    }
  }
}

DEVI void gemm32_direct(const u16* __restrict__ arow, const u16* __restrict__ brow, int K, f32x16& acc, int h) {
  arow += 8 * h;
  brow += 8 * h;
#pragma unroll 2
  for (int k0 = 0; k0 < K; k0 += 64) {
    bf8 a[4], b[4];
#pragma unroll
    for (int s = 0; s < 4; ++s) { a[s] = *(const bf8*)(arow + k0 + 16 * s); b[s] = *(const bf8*)(brow + k0 + 16 * s); }
#pragma unroll
    for (int s = 0; s < 4; ++s) acc = __builtin_amdgcn_mfma_f32_32x32x16_bf16(a[s], b[s], acc, 0, 0, 0);
  }
}

DEVI void gemm32x128_ksplit(const u16* __restrict__ arow, const u16* __restrict__ bt, long ldb, int K, float* out, int wid, int lane) {
  const int h = lane >> 5;
  const int kq = K >> 2;
  f32x16 acc[4];
#pragma unroll
  for (int c = 0; c < 4; ++c)
#pragma unroll
    for (int r = 0; r < 16; ++r) acc[c][r] = 0.f;
  const u16* ap = arow + wid * kq + 8 * h;
  const u16* bp = bt + (long)(lane & 31) * ldb + wid * kq + 8 * h;
#pragma unroll 1
  for (int k0 = 0; k0 < kq; k0 += 64) {
    bf8 a[4];
#pragma unroll
    for (int s = 0; s < 4; ++s) a[s] = *(const bf8*)(ap + k0 + 16 * s);
#pragma unroll
    for (int c2 = 0; c2 < 4; c2 += 2) {
      bf8 b[2][4];
#pragma unroll
      for (int c = 0; c < 2; ++c)
#pragma unroll
        for (int s = 0; s < 4; ++s) b[c][s] = *(const bf8*)(bp + (long)(c2 + c) * 32 * ldb + k0 + 16 * s);
#pragma unroll
      for (int c = 0; c < 2; ++c)
#pragma unroll
        for (int s = 0; s < 4; ++s) acc[c2 + c] = __builtin_amdgcn_mfma_f32_32x32x16_bf16(a[s], b[c][s], acc[c2 + c], 0, 0, 0);
      __builtin_amdgcn_sched_barrier(0);
    }
  }
#pragma unroll 1
  for (int w = 0; w < 4; ++w) {
    if (wid == w) {
#pragma unroll
      for (int c = 0; c < 4; ++c)
#pragma unroll
        for (int r = 0; r < 16; ++r) {
          float* o = out + ((r & 3) + 8 * (r >> 2) + 4 * h) * 129 + c * 32 + (lane & 31);
          *o = (w == 0) ? acc[c][r] : *o + acc[c][r];
        }
    }
    __syncthreads();
  }
}

DEVI float gelu_tanh(float x) {
  const float u = 0.7978845608028654f * (x + 0.044715f * x * x * x);
  return 0.5f * x * (1.f + tanhf(u));
}

DEVI void item_s2(const Params& p, int l, int bsel, int it2, char* smem) {
  const int tid = get_tid(), lane = tid & 63, wid = tid >> 6, h = lane >> 5;
  const float* MISC = (const float*)(p.ws + OFF_MISC);
  float* CL = (float*)(p.ws + OFF_CL);
  const u16* CH = (const u16*)(p.ws + OFF_CH);
  const u16* WC1 = (const u16*)(p.ws + OFF_WC1);
  const float* CBP = (const float*)(p.ws + OFF_CBP);
  u16* KCMP = (u16*)(p.ws + OFF_KCMP);
  u16* VCMPT = (u16*)(p.ws + OFF_VCMPT);
  {
    if (it2 < 4) {
      const int b = bsel, hh = it2;
      const float fb = p.in[2][l * 4 + hh];
      double* part = (double*)smem;
      double loc[8];
      double run = 0.0;
#pragma unroll
      for (int j = 0; j < 8; ++j) {
        const int t = tid * 8 + j;
        const float f = MISC[(size_t)(b * T_ + t) * 32 + hh] + fb;
        const float ls = fminf(f, 0.f) - log1pf(__expf(-fabsf(f)));
        run += (double)ls;
        loc[j] = run;
      }
      part[tid] = run;
      __syncthreads();
      if (tid == 0) {
        double sacc = 0.0;
        for (int j = 0; j < 256; ++j) { const double v = part[j]; part[j] = sacc; sacc += v; }
      }
      __syncthreads();
      const double base = part[tid];
#pragma unroll
      for (int j = 0; j < 8; ++j) CL[(size_t)(b * 4 + hh) * T_ + tid * 8 + j] = (float)(-(base + loc[j]) * (double)LOG2E);
      __syncthreads();
      return;
    }
    const int it = it2 - 4;
    const int ch = it & 3, kv = (it >> 2) & 1, g = (it >> 3) & 1, b = bsel;
    const u16* A = CH + (size_t)((kv ? CH_NSAVC : CH_NSAKC) + g) * CHSZ + (size_t)b * T_ * 64;
    int c = ch * 32 + (lane & 31);
    c = c > 126 ? 126 : c;
    const float* cbp = CBP + (size_t)(l * 2 + kv) * 8 * 128;
    float* HID = (float*)smem;
    gemm32x128_ksplit(A + (size_t)c * 1024, WC1 + (size_t)(l * 2 + kv) * 128 * 2048, 2048, 2048, HID, wid, lane);
    {
      const int col = tid & 127;
      float bsum = 0.f;
#pragma unroll
      for (int q = 0; q < 8; ++q) bsum += cbp[q * 128 + col];
#pragma unroll
      for (int i = 0; i < 16; ++i) {
        float* hp = HID + ((tid >> 7) + 2 * i) * 129 + col;
        *hp = gelu_tanh(*hp + bsum);
      }
    }
    __syncthreads();
    {
      const float* w2 = p.in[kv ? 8 : 5] + (size_t)l * 128 * 64;
      const int d = tid & 63, rq = tid >> 6;
      float o[8];
#pragma unroll
      for (int r = 0; r < 8; ++r) o[r] = 0.f;
#pragma unroll 4
      for (int k = 0; k < 128; ++k) {
        const float wv = w2[k * 64 + d];
#pragma unroll
        for (int r = 0; r < 8; ++r) o[r] += HID[(rq + 4 * r) * 129 + k] * wv;
      }
#pragma unroll
      for (int r = 0; r < 8; ++r) {
        const int cc = ch * 32 + rq + 4 * r;
        const float v = (cc < 127) ? o[r] : 0.f;
        if (!kv) KCMP[((size_t)(b * 2 + g) * 128 + cc) * 64 + d] = f2bf(v);
        else VCMPT[((size_t)(b * 2 + g) * 64 + d) * 128 + cc] = f2bf(v);
      }
    }
    __syncthreads();
  }
}

DEVI void load_qfrag(const u16* Qrow  , int lane, bf8 (&qf)[4]) {
  const int h = lane >> 5;
#pragma unroll
  for (int s = 0; s < 4; ++s) qf[s] = *(const bf8*)(Qrow + 16 * s + 8 * h);
}

DEVI void load_tile64(const u16* src, long ld, char* lds) {
  const int tid = get_tid();
#pragma unroll
  for (int i = 0; i < 2; ++i) {
    const int pslot = tid + 256 * i, row = pslot >> 3, cp = pslot & 7;
    const int c = cp ^ ((row >> 1) & 7);
    glds16(src + (long)row * ld + c * 8, lds + tid * 16 + i * 4096);
  }
}

enum { M_FOX = 0, M_WIN = 1, M_SLC = 2, M_DSA = 3 };

template <int MODE>
DEVI void flash_block(const bf8 (&qf)[4], const u16* K, const u16* Vt, int q0, int kt0, int kt1, const float* bias,
                      unsigned selm, unsigned umask, const u64* dmrow, char* smem, f32x16 (&O)[2]) {
  const int tid = get_tid(), lane = tid & 63, wid = tid >> 6, h = lane >> 5;
  const int qw0 = q0 + 32 * wid, q = qw0 + (lane & 31);
  O[0] = (f32x16){0.f}; O[1] = (f32x16){0.f};
#pragma unroll
  for (int r = 0; r < 16; ++r) { O[0][r] = 0.f; O[1][r] = 0.f; }
  float mrun = -1e30f, lrun = 0.f;
  const int swk = ((lane & 31) >> 1) & 7;
  u64 um64 = ~0ull;
  if (MODE == M_SLC) um64 = (u64)umask;
  um64 &= (kt1 >= 64 ? ~0ull : ((1ull << kt1) - 1ull)) & (~0ull << kt0);
  auto issue = [&](int kt, int buf) {
    char* base = smem + buf * 16896;
    const int k0 = kt * 64;
    load_tile64(K + (long)k0 * 64, 64, base);
    load_tile64(Vt + k0, T_, base + 8192);
    if (MODE == M_FOX) { if (tid < 16) glds16(bias + k0 + tid * 4, base + 16384 + tid * 16); }
  };
  __syncthreads();
  int kt = um64 ? (int)__builtin_ctzll(um64) : 64;
  u64 dm_pref = 0;
  if (MODE == M_DSA) { if (kt < 64) dm_pref = dmrow[kt]; }
  if (kt < 64) issue(kt, 0);
  int cur = 0;
  while (kt < 64) {
    const u64 rem = (kt >= 63) ? 0ull : (um64 & (~0ull << (kt + 1)));
    const int nxt = rem ? (int)__builtin_ctzll(rem) : 64;
    wait_vm0();
    __syncthreads();
    u64 dm_next = 0;
    if (MODE == M_DSA) { dm_next = dm_pref; if (nxt < 64) dm_pref = dmrow[nxt]; }
    if (nxt < 64) issue(nxt, cur ^ 1);
    const char* SK = smem + cur * 16896;
    const char* SV = SK + 8192;
    const float* SBias = (const float*)(SK + 16384);
    const int k0 = kt * 64;
    bool active = true;
    if (MODE != M_DSA) active = (k0 <= qw0 + 31);
    if (MODE == M_WIN) active = active && (k0 + 63 >= qw0 - 511);
    u64 dm = 0;
    if (MODE == M_DSA) { dm = dm_next; }
    if (active) {
      f32x16 S[2];
#pragma unroll
      for (int tk = 0; tk < 2; ++tk) {
        if (MODE == M_FOX) {
#pragma unroll
          for (int g4 = 0; g4 < 4; ++g4) {
            const f32x4 bv = *(const f32x4*)(SBias + 32 * tk + 8 * g4 + 4 * h);
#pragma unroll
            for (int e = 0; e < 4; ++e) S[tk][4 * g4 + e] = bv[e];
          }
        } else if (MODE == M_SLC) {
          const float iv = ((selm >> kt) & 1u) ? 0.f : -INFINITY;
#pragma unroll
          for (int r = 0; r < 16; ++r) S[tk][r] = iv;
        } else if (MODE == M_DSA) {
          const unsigned w4 = (tk ? (unsigned)(dm >> 32) : (unsigned)dm) >> (4 * h);
#pragma unroll
          for (int g4 = 0; g4 < 4; ++g4)
#pragma unroll
            for (int e = 0; e < 4; ++e)
              S[tk][4 * g4 + e] = __uint_as_float(~(unsigned)__builtin_amdgcn_sbfe((int)w4, 8 * g4 + e, 1) & 0xff800000u);
        } else {
#pragma unroll
          for (int r = 0; r < 16; ++r) S[tk][r] = 0.f;
        }
        __builtin_amdgcn_s_setprio(1);
#pragma unroll
        for (int s = 0; s < 4; ++s) {
          const bf8 kf = *(const bf8*)(SK + (32 * tk + (lane & 31)) * 128 + (((2 * s + h) ^ swk) << 4));
          S[tk] = __builtin_amdgcn_mfma_f32_32x32x16_bf16(kf, qf[s], S[tk], 0, 0, 0);
        }
        __builtin_amdgcn_s_setprio(0);
      }
      const bool diag = (MODE != M_DSA) && (k0 + 63 > qw0);
      const bool lowb = (MODE == M_WIN) && (k0 < qw0 + 31 - 511);
      if (diag || lowb) {
#pragma unroll
        for (int tk = 0; tk < 2; ++tk)
#pragma unroll
          for (int r = 0; r < 16; ++r) {
            const int key = k0 + 32 * tk + 8 * (r >> 2) + 4 * h + (r & 3);
            bool valid = key <= q;
            if (MODE == M_WIN) valid = valid && (key > q - 512);
            S[tk][r] = valid ? S[tk][r] : -INFINITY;
          }
      }
      float mx = fmaxf(S[0][0], S[1][0]);
#pragma unroll
      for (int r = 1; r < 16; ++r) mx = fmaxf(mx, fmaxf(S[0][r], S[1][r]));
      mx = fmaxf(mx, __shfl_xor(mx, 32));
      const float mnew = fmaxf(mrun, mx);
      const float alpha = fexp2(mrun - mnew);
      const bool grew = mnew > mrun;
      mrun = mnew;
      float ps = 0.f;
      bf8 pf[2][2];
#pragma unroll
      for (int tk = 0; tk < 2; ++tk)
#pragma unroll
        for (int r = 0; r < 16; ++r) {
          const float pv = fexp2(S[tk][r] - mnew);
          ps += pv;
          pf[tk][r >> 3][r & 7] = (__bf16)pv;
        }
      lrun = lrun * alpha + ps;
      if (__any(grew)) {
#pragma unroll
        for (int r = 0; r < 16; ++r) { O[0][r] *= alpha; O[1][r] *= alpha; }
      }
      __builtin_amdgcn_sched_barrier(0);
      __builtin_amdgcn_s_setprio(1);
#pragma unroll
      for (int dt = 0; dt < 2; ++dt) {
        const int d = 32 * dt + (lane & 31);
        const char* vrow = SV + d * 128;
        const int swv = (d >> 1) & 7;
#pragma unroll
        for (int tk = 0; tk < 2; ++tk)
#pragma unroll
          for (int s = 0; s < 2; ++s) {
            const int c1 = 4 * tk + 2 * s;
            const bf4 lo = *(const bf4*)(vrow + ((c1 ^ swv) << 4) + 8 * h);
            const bf4 hi = *(const bf4*)(vrow + (((c1 + 1) ^ swv) << 4) + 8 * h);
            bf8 vf;
            vf[0] = lo[0]; vf[1] = lo[1]; vf[2] = lo[2]; vf[3] = lo[3];
            vf[4] = hi[0]; vf[5] = hi[1]; vf[6] = hi[2]; vf[7] = hi[3];
            O[dt] = __builtin_amdgcn_mfma_f32_32x32x16_bf16(vf, pf[tk][s], O[dt], 0, 0, 0);
          }
      }
      __builtin_amdgcn_s_setprio(0);
    }
    kt = nxt;
    cur ^= 1;
  }
  const float lt = lrun + __shfl_xor(lrun, 32);
  const float inv = lt > 0.f ? 1.f / lt : 0.f;
#pragma unroll
  for (int r = 0; r < 16; ++r) { O[0][r] *= inv; O[1][r] *= inv; }
}

DEVI void store_o(const f32x16 (&O)[2], u16* orow  , int lane) {
  const int h = lane >> 5;
#pragma unroll
  for (int dt = 0; dt < 2; ++dt)
#pragma unroll
    for (int g4 = 0; g4 < 4; ++g4)
      *(uint2*)(orow + 32 * dt + 8 * g4 + 4 * h) = pk4(O[dt][4 * g4], O[dt][4 * g4 + 1], O[dt][4 * g4 + 2], O[dt][4 * g4 + 3]);
}

DEVI void item_fox(const Params& p, int b, int h, int qb, char* smem) {
  const int tid = get_tid(), lane = tid & 63, wid = tid >> 6;
  const u16* CH = (const u16*)(p.ws + OFF_CH);
  const u16* Q = CH + (size_t)(CH_FOXQ + h) * CHSZ + (size_t)b * T_ * 64;
  const u16* K = CH + (size_t)(CH_FOXK + h) * CHSZ + (size_t)b * T_ * 64;
  const u16* Vt = CH + (size_t)(CH_FOXV + h) * CHSZ + (size_t)b * 64 * T_;
  const float* bias = (const float*)(p.ws + OFF_CL) + (size_t)(b * 4 + h) * T_;
  const int q0 = qb * 128, q = q0 + 32 * wid + (lane & 31);
  bf8 qf[4];
  load_qfrag(Q + (size_t)q * 64, lane, qf);
  f32x16 O[2];
  flash_block<M_FOX>(qf, K, Vt, q0, 0, q0 / 64 + 2, bias, 0u, 0u, nullptr, smem, O);
  u16* o = (u16*)(p.ws + OFF_O) + (size_t)(b * T_ + q) * DM + h * 64;
  store_o(O, o, lane);
}

DEVI void item_cmp(const Params& p, int b, int g, int qb, char* smem) {
  const int tid = get_tid(), lane = tid & 63, wid = tid >> 6, h = lane >> 5;
  const int bg = b * 2 + g;
  const u16* CH = (const u16*)(p.ws + OFF_CH);
  const u16* KC = (const u16*)(p.ws + OFF_KCMP) + (size_t)bg * 128 * 64;
  const u16* VCT = (const u16*)(p.ws + OFF_VCMPT) + (size_t)bg * 64 * 128;
  const float* MISC = (const float*)(p.ws + OFF_MISC);
  float* OCMP = (float*)(p.ws + OFF_OCMP);
  unsigned* SELM = (unsigned*)(p.ws + OFF_SELM);
  char* SK = smem;
  char* SV = smem + 16384;
  load_tile64(KC, 64, SK);
  load_tile64(KC + 64 * 64, 64, SK + 8192);
#pragma unroll
  for (int j = 0; j < 4; ++j) {
    const int pslot = tid + 256 * j, row = pslot >> 4, cp = pslot & 15;
    const int c = cp ^ ((row >> 1) & 7);
    glds16(VCT + (size_t)row * 128 + c * 8, SV + tid * 16 + j * 4096);
  }
  wait_vm0();
  __syncthreads();
  const int q0 = qb * 128, qw0 = q0 + 32 * wid, t = qw0 + (lane & 31);
  const int tok = b * T_ + t;
  const int swk = ((lane & 31) >> 1) & 7;
  float* GLg = (float*)(smem + 32768) + wid * 2112 + (lane & 31) * 33;
  float* GLl = GLg + 1056;
#pragma unroll
  for (int j = 0; j < 16; ++j) { GLg[2 * j + h] = 0.f; GLl[2 * j + h] = 0.f; }
  int nvis = t >= 31 ? ((t - 31) >> 4) + 1 : 0;
  nvis = nvis > 127 ? 127 : nvis;
#pragma unroll 1
  for (int r3 = 0; r3 < 3; ++r3) {
    const int head = g * 3 + r3;
    bf8 qf[4];
    load_qfrag(CH + (size_t)(CH_NSAQ + head) * CHSZ + (size_t)tok * 64, lane, qf);
    int nv = nvis;
    asm volatile("" : "+v"(nv));
    float mrun = -1e30f, lrun = 0.f;
#pragma unroll 1
    for (int tk = 0; tk < 4; ++tk) {
      f32x16 S;
#pragma unroll
      for (int r = 0; r < 16; ++r) S[r] = 0.f;
#pragma unroll
      for (int s = 0; s < 4; ++s) {
        const bf8 kf = *(const bf8*)(SK + (32 * tk + (lane & 31)) * 128 + (((2 * s + h) ^ swk) << 4));
        S = __builtin_amdgcn_mfma_f32_32x32x16_bf16(kf, qf[s], S, 0, 0, 0);
      }
      float mx = -INFINITY;
#pragma unroll
      for (int r = 0; r < 16; ++r) {
        const int c = 32 * tk + 8 * (r >> 2) + 4 * h + (r & 3);
        const bool valid = c < nv;
        const float sv = valid ? S[r] : -INFINITY;
        S[r] = sv;
        mx = fmaxf(mx, sv);
      }
      mx = fmaxf(mx, __shfl_xor(mx, 32));
      const float mnew = fmaxf(mrun, mx);
      float ps = 0.f;
#pragma unroll
      for (int r = 0; r < 16; ++r) ps += fexp2(S[r] - mnew);
      lrun = lrun * fexp2(mrun - mnew) + ps;
      mrun = mnew;
    }
    const float lt = lrun + __shfl_xor(lrun, 32);
    const float inv = lt > 0.f ? 1.f / lt : 0.f;
    asm volatile("" : "+v"(nv));
    f32x16 O[2];
#pragma unroll
    for (int r = 0; r < 16; ++r) { O[0][r] = 0.f; O[1][r] = 0.f; }
#pragma unroll
    for (int tk = 0; tk < 4; ++tk) {
      f32x16 S;
#pragma unroll
      for (int r = 0; r < 16; ++r) S[r] = 0.f;
#pragma unroll
      for (int s = 0; s < 4; ++s) {
        const bf8 kf = *(const bf8*)(SK + (32 * tk + (lane & 31)) * 128 + (((2 * s + h) ^ swk) << 4));
        S = __builtin_amdgcn_mfma_f32_32x32x16_bf16(kf, qf[s], S, 0, 0, 0);
      }
      bf8 pf[2];
#pragma unroll
      for (int r = 0; r < 16; ++r) {
        const int c = 32 * tk + 8 * (r >> 2) + 4 * h + (r & 3);
        const bool valid = c < nv;
        const float pv = valid ? fexp2(S[r] - mrun) * inv : 0.f;
        S[r] = pv;
        pf[r >> 3][r & 7] = (__bf16)pv;
      }
#pragma unroll
      for (int g4 = 0; g4 < 4; ++g4) {
        const int j = 2 * (4 * tk + g4) + h;
        GLg[j] += (S[4 * g4] + S[4 * g4 + 1]) + (S[4 * g4 + 2] + S[4 * g4 + 3]);
        GLl[j] += S[4 * g4 + 3];
      }
#pragma unroll
      for (int dt = 0; dt < 2; ++dt) {
        const int d = 32 * dt + (lane & 31);
        const char* vrow = SV + d * 256;
        const int swv = (d >> 1) & 7;
#pragma unroll
        for (int s = 0; s < 2; ++s) {
          const int c1 = 4 * tk + 2 * s;
          const bf4 lo = *(const bf4*)(vrow + ((c1 ^ swv) << 4) + 8 * h);
          const bf4 hi = *(const bf4*)(vrow + (((c1 + 1) ^ swv) << 4) + 8 * h);
          bf8 vf;
          vf[0] = lo[0]; vf[1] = lo[1]; vf[2] = lo[2]; vf[3] = lo[3];
          vf[4] = hi[0]; vf[5] = hi[1]; vf[6] = hi[2]; vf[7] = hi[3];
          O[dt] = __builtin_amdgcn_mfma_f32_32x32x16_bf16(vf, pf[s], O[dt], 0, 0, 0);
        }
      }
      __builtin_amdgcn_sched_barrier(0);
    }
    const float gate = sigmoidf_(MISC[(size_t)tok * 32 + 4 + head]);
    float* oc = OCMP + (size_t)tok * 384 + head * 64;
#pragma unroll
    for (int dt = 0; dt < 2; ++dt)
#pragma unroll
      for (int g4 = 0; g4 < 4; ++g4) {
        f32x4 v = (f32x4){O[dt][4 * g4] * gate, O[dt][4 * g4 + 1] * gate, O[dt][4 * g4 + 2] * gate, O[dt][4 * g4 + 3] * gate};
        *(f32x4*)(oc + 32 * dt + 8 * g4 + 4 * h) = v;
      }
  }
  {
    const int blk_t = t >> 6;
    float w[32];
#pragma unroll
    for (int k = 0; k < 32; ++k) {
      const int j = (k + h) & 31;
      float x = GLg[j] + (j > 0 ? GLl[j > 0 ? j - 1 : 0] : 0.f);
      const bool forced = (j == 0) || (j == blk_t) || (j == blk_t - 1);
      x = (j <= blk_t) ? (forced ? 1e6f : x) : -1.f;
      w[k] = x;
    }
    unsigned mask = 0;
#pragma unroll
    for (int jj = 0; jj < 16; ++jj) {
      const int k0 = 2 * jj;
      const float vj = w[k0];
      int rank = 0;
#pragma unroll
      for (int k = 0; k < 32; ++k) {
        const bool lower = (k < k0) || (k == 31 && h);
        rank += (w[k] > vj) || (w[k] == vj && lower);
      }
      if (rank < 16) mask |= 1u << (k0 + h);
    }
    mask |= __shfl_xor(mask, 32);
    if (h == 0) SELM[(size_t)bg * T_ + t] = mask;
  }
  __syncthreads();
}

template <int NJ>
DEVI void idx_select(const float* scr, u64* DMASK, int b, int q0, int wid, int lane) {
  auto load_keys = [&](int rr, float (&raw)[NJ]) {
    if (q0 + rr >= 256) {
      const float* src = scr + (size_t)rr * 2048 + lane;
#pragma unroll
      for (int j = 0; j < NJ; ++j) raw[j] = __builtin_nontemporal_load(src + 64 * j);
    }
  };
  auto select_row = [&](int rr, const float (&raw)[NJ]) {
    const int tr = q0 + rr;
    u64* drow = DMASK + (size_t)(b * T_ + tr) * 32;
    if (tr < 256) {
      if (lane < 32) {
        const int lo = lane * 64;
        drow[lane] = (tr >= lo + 63) ? ~0ull : (tr < lo ? 0ull : ((2ull << (tr - lo)) - 1ull));
      }
      return;
    }
    unsigned key[NJ];
#pragma unroll
    for (int j = 0; j < NJ; ++j) {
      const unsigned bits = __float_as_uint(raw[j]);
      const unsigned kk = (bits & 0x80000000u) ? ~bits : (bits | 0x80000000u);
      key[j] = (lane + 64 * j <= tr) ? kk : 0u;
    }
    unsigned prefix = 0u;
    for (int bit = 31; bit >= 0; --bit) {
      const unsigned cand = prefix | (1u << bit);
      int cl = 0;
#pragma unroll
      for (int j = 0; j < NJ; ++j) cl += (key[j] >= cand) ? 1 : 0;
      int c = 0;
#pragma unroll
      for (int sb = 0; sb < 6; ++sb) c += __popcll(__ballot((cl >> sb) & 1)) << sb;
      if (c >= 256) prefix = cand;
      if (c == 256) break;
    }
    int cgl = 0;
#pragma unroll
    for (int j = 0; j < NJ; ++j) cgl += (key[j] > prefix) ? 1 : 0;
    int cgt = 0;
#pragma unroll
    for (int sb = 0; sb < 6; ++sb) cgt += __popcll(__ballot((cgl >> sb) & 1)) << sb;
    int need = 256 - cgt;
    const u64 lt_mask = (1ull << lane) - 1ull;
#pragma unroll
    for (int j = 0; j < NJ; ++j) {
      const u64 eqm = __ballot(key[j] == prefix);
      const int myrank = __popcll(eqm & lt_mask);
      const bool sel = (key[j] > prefix) || (key[j] == prefix && myrank < need);
      need -= __popcll(eqm);
      const u64 word = __ballot(sel);
      if (lane == 0) drow[j] = word;
    }
    if (NJ < 32) { if (lane >= NJ && lane < 32) drow[lane] = 0ull; }
  };
  float ka[NJ], kb[NJ];
  load_keys(wid * 8, ka);
#pragma unroll 1
  for (int r2 = 0; r2 < 4; ++r2) {
    const int rr = wid * 8 + 2 * r2;
    load_keys(rr + 1, kb);
    select_row(rr, ka);
    if (r2 < 3) load_keys(rr + 2, ka);
    select_row(rr + 1, kb);
  }
}

DEVI void item_idx(const Params& p, int b, int qb, char* smem, int pflags) {
  const int tid = get_tid(), lane = tid & 63, wid = tid >> 6, h = lane >> 5;
  const u16* CH = (const u16*)(p.ws + OFF_CH);
  const u16* KI = CH + (size_t)CH_IDXK * CHSZ + (size_t)b * T_ * 64;
  const float* MISC = (const float*)(p.ws + OFF_MISC);
  float* scr = (float*)(p.ws + OFF_DSCR) + (size_t)blockIdx.x * 32 * 2048;
  u64* DMASK = (u64*)(p.ws + ((pflags & 16) ? WS_NEED : OFF_DMASK));
  const int q0 = qb * 32, t = q0 + (lane & 31), tok = b * T_ + t;
  const int nkt = q0 / 64 + 1;
  if (!(pflags & 16)) {
    bf8 qf[4][4];
    float w[4];
#pragma unroll
    for (int hd = 0; hd < 4; ++hd) {
      load_qfrag(CH + (size_t)(CH_IDXQ + hd) * CHSZ + (size_t)tok * 64, lane, qf[hd]);
      w[hd] = MISC[(size_t)tok * 32 + 22 + hd];
    }
    for (int kt = wid; kt < nkt; kt += 4) {
      const int k0 = kt * 64;
#pragma unroll
      for (int tk = 0; tk < 2; ++tk) {
        bf8 kf[4];
        const u16* krow = KI + (size_t)(k0 + 32 * tk + (lane & 31)) * 64;
#pragma unroll
        for (int s = 0; s < 4; ++s) kf[s] = *(const bf8*)(krow + 16 * s + 8 * h);
        f32x16 sc;
#pragma unroll
        for (int r = 0; r < 16; ++r) sc[r] = 0.f;
#pragma unroll
        for (int hd = 0; hd < 4; ++hd) {
          f32x16 S;
#pragma unroll
          for (int r = 0; r < 16; ++r) S[r] = 0.f;
#pragma unroll
          for (int s = 0; s < 4; ++s) S = __builtin_amdgcn_mfma_f32_32x32x16_bf16(kf[s], qf[hd][s], S, 0, 0, 0);
#pragma unroll
          for (int r = 0; r < 16; ++r) sc[r] += w[hd] * fmaxf(S[r], 0.f);
        }
        float* dst = scr + (size_t)(lane & 31) * 2048 + k0 + 32 * tk + 4 * h;
#pragma unroll
        for (int g4 = 0; g4 < 4; ++g4)
          *(f32x4*)(dst + 8 * g4) = (f32x4){sc[4 * g4] + 0.f, sc[4 * g4 + 1] + 0.f, sc[4 * g4 + 2] + 0.f, sc[4 * g4 + 3] + 0.f};
      }
    }
  }
  wait_vm0();
  __syncthreads();
  if (!(pflags & 8)) {
    const int njr = (nkt + 7) >> 3;
    if (njr <= 1) idx_select<8>(scr, DMASK, b, q0, wid, lane);
    else if (njr == 2) idx_select<16>(scr, DMASK, b, q0, wid, lane);
    else if (njr == 3) idx_select<24>(scr, DMASK, b, q0, wid, lane);
    else idx_select<32>(scr, DMASK, b, q0, wid, lane);
  }
  __syncthreads();
}

DEVI void phase_s3a(const Params& p, int l, char* smem, int psub) {
  const int b = blockIdx.x & 7;
  unsigned* bar = (unsigned*)(p.ws + OFF_BAR);
  unsigned* ctr = bar + XB_WCTR + (l * 2) * 8 + b;
  unsigned* s2done = bar + XB_WCTR + 320 + (l & 15) * 8 + b;
  const unsigned s2need = (l >= 16) ? 40u : 20u;
  bool s2ready = false;
  for (int it = next_item(ctr, smem); it < 180; it = next_item(ctr, smem)) {
    if (it < 20) {
      item_s2(p, l & 15, b, it, smem);
      wait_vm0();
      __syncthreads();
      if (threadIdx.x == 0) {
        __builtin_amdgcn_fence(__ATOMIC_RELEASE, "agent");
        asm volatile("s_waitcnt vmcnt(0)" ::: "memory");
        (void)xb_add(s2done, 1u);
      }
      continue;
    }
    const int i2 = it - 20;
    if (l >= 16) {
      if (i2 < 64) { if (!(psub & 1)) continue; }
      else if (i2 < 128) { if (!(psub & 2)) continue; }
      else { if (!(psub & 4)) continue; }
    }
    if (i2 >= 64 && !s2ready) {
      if (threadIdx.x == 0) {
        XB_SPIN(xb_ld(s2done) < s2need, bar);
        __builtin_amdgcn_fence(__ATOMIC_ACQUIRE, "agent");
        asm volatile("s_waitcnt vmcnt(0)" ::: "memory");
      }
      __syncthreads();
      s2ready = true;
    }
    if (i2 < 64) item_idx(p, b, 63 - i2, smem, l >= 16 ? psub : 0);
    else if (i2 < 128) item_fox(p, b, (i2 - 64) & 3, 15 - ((i2 - 64) >> 2), smem);
    else item_cmp(p, b, (i2 - 128) >> 4, (i2 - 128) & 15, smem);
  }
}

DEVI void item_nsa(const Params& p, int b, int head, int qb, char* smem) {
  const int tid = get_tid(), lane = tid & 63, wid = tid >> 6, h = lane >> 5;
  const int g = head / 3;
  const u16* CH = (const u16*)(p.ws + OFF_CH);
  const float* MISC = (const float*)(p.ws + OFF_MISC);
  const int q0 = qb * 128, q = q0 + 32 * wid + (lane & 31), tok = b * T_ + q;
  bf8 qf[4];
  load_qfrag(CH + (size_t)(CH_NSAQ + head) * CHSZ + (size_t)tok * 64, lane, qf);
  const unsigned selm = ((const unsigned*)(p.ws + OFF_SELM))[(size_t)(b * 2 + g) * T_ + q];
  unsigned um = selm;
#pragma unroll
  for (int o = 32; o > 0; o >>= 1) um |= __shfl_xor(um, o);
  unsigned* red = (unsigned*)(smem + 40960);
  if (lane == 0) red[wid] = um;
  __syncthreads();
  um = red[0] | red[1] | red[2] | red[3];
  __syncthreads();
  f32x16 O1[2], O2[2];
  flash_block<M_SLC>(qf, CH + (size_t)(CH_NSAKS + g) * CHSZ + (size_t)b * T_ * 64,
                     CH + (size_t)(CH_NSAVS + g) * CHSZ + (size_t)b * 64 * T_, q0, 0, q0 / 64 + 2, nullptr, selm, um, nullptr, smem, O1);
  int kt0 = (q0 - 511) >> 6;
  kt0 = kt0 < 0 ? 0 : kt0;
  flash_block<M_WIN>(qf, CH + (size_t)(CH_NSAKW + g) * CHSZ + (size_t)b * T_ * 64,
                     CH + (size_t)(CH_NSAVW + g) * CHSZ + (size_t)b * 64 * T_, q0, kt0, q0 / 64 + 2, nullptr, 0u, 0u, nullptr, smem, O2);
  const float g1 = sigmoidf_(MISC[(size_t)tok * 32 + 4 + 6 + head]);
  const float g2 = sigmoidf_(MISC[(size_t)tok * 32 + 4 + 12 + head]);
  const float* oc = (const float*)(p.ws + OFF_OCMP) + (size_t)tok * 384 + head * 64;
  u16* o = (u16*)(p.ws + OFF_O) + (size_t)tok * DM + 256 + head * 64;
#pragma unroll
  for (int dt = 0; dt < 2; ++dt)
#pragma unroll
    for (int g4 = 0; g4 < 4; ++g4) {
      const int d = 32 * dt + 8 * g4 + 4 * h;
      const f32x4 c = *(const f32x4*)(oc + d);
      float v[4];
#pragma unroll
      for (int e = 0; e < 4; ++e) v[e] = c[e] + g1 * O1[dt][4 * g4 + e] + g2 * O2[dt][4 * g4 + e];
      *(uint2*)(o + d) = pk4(v[0], v[1], v[2], v[3]);
    }
}

DEVI void item_dsa(const Params& p, int b, int head, int qb, char* smem) {
  const int tid = get_tid(), lane = tid & 63, wid = tid >> 6;
  const u16* CH = (const u16*)(p.ws + OFF_CH);
  const int q0 = qb * 128, q = q0 + 32 * wid + (lane & 31), tok = b * T_ + q;
  bf8 qf[4];
  load_qfrag(CH + (size_t)(CH_DSAQ + head) * CHSZ + (size_t)tok * 64, lane, qf);
  const u64* dmrow = (const u64*)(p.ws + OFF_DMASK) + (size_t)tok * 32;
  f32x16 O[2];
  flash_block<M_DSA>(qf, CH + (size_t)CH_DSAK * CHSZ + (size_t)b * T_ * 64, CH + (size_t)CH_DSAV * CHSZ + (size_t)b * 64 * T_, q0, 0,
                     q0 / 64 + 2, nullptr, 0u, 0u, dmrow, smem, O);
  u16* o = (u16*)(p.ws + OFF_O) + (size_t)tok * DM + 640 + head * 64;
  store_o(O, o, lane);
}

DEVI void phase_s3b(const Params& p, int l, char* smem, int psub) {
  const int b = blockIdx.x & 7;
  unsigned* ctr = (unsigned*)(p.ws + OFF_BAR) + XB_WCTR + (l * 2 + 1) * 8 + b;
  for (int it = next_item(ctr, smem); it < 192; it = next_item(ctr, smem)) {
    const int j = it >> 1;
    if (l >= 16) { if (!((psub >> (it & 1)) & 1)) continue; }
    if (it & 1) item_dsa(p, b, j % 6, 15 - j / 6, smem);
    else item_nsa(p, b, j % 6, 15 - j / 6, smem);
  }
}

DEVI void phase_outproj(const Params& p, int l, char* smem) {
  const int tid = get_tid(), lane = tid & 63, wid = tid >> 6, wr = wid >> 1, wc = wid & 1;
  const u16* O = (const u16*)(p.ws + OFF_O);
  const u16* WO = (const u16*)(p.ws + OFF_WO) + (size_t)l * DM * DM;
  const float* xin = l == 0 ? p.in[0] : (const float*)(p.ws + OFF_XBUF);
  float* h1 = (float*)(p.ws + OFF_XBUF);
  XCD_LOOP(it, 128 * 8) {
    const int mt = it >> 3, nt = it & 7;
    long aoff[4];
#pragma unroll
    for (int q = 0; q < 4; ++q) aoff[q] = (long)(mt * 128 + (tid >> 3) + 32 * q) * DM;
    f32x4 acc[4][4];
    gemm128(O, aoff, WO, DM, nt * 128, DM, smem, acc);
#pragma unroll
    for (int m = 0; m < 4; ++m) {
      const size_t row = mt * 128 + wr * 64 + m * 16 + (lane & 15);
      const int col0 = nt * 128 + wc * 64 + 16 * (lane >> 4);
#pragma unroll
      for (int n = 0; n < 4; ++n) {
        const f32x4 xv = *(const f32x4*)(xin + row * DM + col0 + 4 * n);
        f32x4 v;
#pragma unroll
        for (int q = 0; q < 4; ++q) v[q] = ALPHA * xv[q] + acc[m][n][q];
        *(f32x4*)(h1 + row * DM + col0 + 4 * n) = v;
      }
    }
  }
}

DEVI void ln_row(float (&v)[16], const float* g, const float* bta, int lane) {
  float s = 0.f;
#pragma unroll
  for (int j = 0; j < 16; ++j) s += v[j];
  const float mu = wave_sum(s) * (1.f / DM);
  float s2 = 0.f;
#pragma unroll
  for (int j = 0; j < 16; ++j) { const float d = v[j] - mu; s2 += d * d; }
  const float rstd = rsqrtf(wave_sum(s2) * (1.f / DM) + LN_EPS);
#pragma unroll
  for (int i = 0; i < 4; ++i) {
    const int c = lane * 4 + 256 * i;
    const float4 gg = *(const float4*)(g + c), bb = *(const float4*)(bta + c);
    v[4 * i + 0] = (v[4 * i + 0] - mu) * rstd * gg.x + bb.x;
    v[4 * i + 1] = (v[4 * i + 1] - mu) * rstd * gg.y + bb.y;
    v[4 * i + 2] = (v[4 * i + 2] - mu) * rstd * gg.z + bb.z;
    v[4 * i + 3] = (v[4 * i + 3] - mu) * rstd * gg.w + bb.w;
  }
}

DEVI void ln_row8(float (&v)[16], const float* g, const float* bta, int lane) {
  float s = 0.f;
#pragma unroll
  for (int j = 0; j < 16; ++j) s += v[j];
  const float mu = wave_sum(s) * (1.f / DM);
  float s2 = 0.f;
#pragma unroll
  for (int j = 0; j < 16; ++j) { const float d = v[j] - mu; s2 += d * d; }
  const float rstd = rsqrtf(wave_sum(s2) * (1.f / DM) + LN_EPS);
#pragma unroll
  for (int i = 0; i < 2; ++i) {
    const int c = lane * 8 + 512 * i;
#pragma unroll
    for (int h = 0; h < 2; ++h) {
      const float4 gg = *(const float4*)(g + c + 4 * h), bb = *(const float4*)(bta + c + 4 * h);
      v[8 * i + 4 * h + 0] = (v[8 * i + 4 * h + 0] - mu) * rstd * gg.x + bb.x;
      v[8 * i + 4 * h + 1] = (v[8 * i + 4 * h + 1] - mu) * rstd * gg.y + bb.y;
      v[8 * i + 4 * h + 2] = (v[8 * i + 4 * h + 2] - mu) * rstd * gg.z + bb.z;
      v[8 * i + 4 * h + 3] = (v[8 * i + 4 * h + 3] - mu) * rstd * gg.w + bb.w;
    }
  }
}

DEVI void phase_ln1_router(const Params& p, int l, char* smem, int dup) {
  const int tid = get_tid(), lane = tid & 63, wid = tid >> 6, h = lane >> 5;
  const float* h1 = (const float*)(p.ws + OFF_XBUF);
  u8* X8 = (u8*)(p.ws + OFF_XA);
  u16* XB = (u16*)(p.ws + OFF_XB);
  u16* XL = (u16*)(p.ws + OFF_XL);
  const float* g1 = p.in[10] + l * DM;
  const float* b1 = p.in[11] + l * DM;
  const u16* WR2 = (const u16*)(p.ws + OFF_WR2) + (size_t)l * 128 * 2048;
  const float* BR = p.in[13] + l * NE;
  unsigned* CNT = (unsigned*)(p.ws + OFF_CNT) + l * 128 + 64 * dup;
  unsigned* LIST = (unsigned*)(p.ws + OFF_LIST);
  float* LISTW = (float*)(p.ws + OFF_LISTW);
  float* LG = (float*)smem;
  unsigned* lcnt = (unsigned*)(smem + 16640);
  unsigned* lbase = lcnt + 64;
  unsigned* pinfo = lcnt + 128;
  float* pgw = (float*)(pinfo + 256);
  for (int it = blockIdx.x; it < NTOK / 32; it += gridDim.x) {
    {
      const size_t tok0 = (size_t)it * 32 + wid * 8;
      float4 nx[4];
#pragma unroll
      for (int i = 0; i < 2; ++i) {
        nx[2 * i] = *(const float4*)(h1 + tok0 * DM + lane * 8 + 512 * i);
        nx[2 * i + 1] = *(const float4*)(h1 + tok0 * DM + lane * 8 + 512 * i + 4);
      }
#pragma unroll 1
      for (int tt = 0; tt < 8; ++tt) {
        const size_t tok = tok0 + tt;
        float v[16];
#pragma unroll
        for (int i = 0; i < 4; ++i) { v[4 * i] = nx[i].x; v[4 * i + 1] = nx[i].y; v[4 * i + 2] = nx[i].z; v[4 * i + 3] = nx[i].w; }
        if (tt < 7) {
#pragma unroll
          for (int i = 0; i < 2; ++i) {
            nx[2 * i] = *(const float4*)(h1 + (tok + 1) * DM + lane * 8 + 512 * i);
            nx[2 * i + 1] = *(const float4*)(h1 + (tok + 1) * DM + lane * 8 + 512 * i + 4);
          }
        }
        ln_row8(v, g1, b1, lane);
#pragma unroll
        for (int i = 0; i < 2; ++i) {
          const int c = lane * 8 + 512 * i;
          uint4 hi, lo;
          hi.x = pk2(v[8 * i], v[8 * i + 1]); hi.y = pk2(v[8 * i + 2], v[8 * i + 3]);
          hi.z = pk2(v[8 * i + 4], v[8 * i + 5]); hi.w = pk2(v[8 * i + 6], v[8 * i + 7]);
          *(uint4*)(XB + tok * DM + c) = hi;
          *(uint2*)(X8 + tok * DM + c) = make_uint2(pk4_f8c(v[8 * i], v[8 * i + 1], v[8 * i + 2], v[8 * i + 3]),
                                                    pk4_f8c(v[8 * i + 4], v[8 * i + 5], v[8 * i + 6], v[8 * i + 7]));
          lo.x = pk2(v[8 * i] - __uint_as_float(hi.x << 16), v[8 * i + 1] - __uint_as_float(hi.x & 0xffff0000u));
          lo.y = pk2(v[8 * i + 2] - __uint_as_float(hi.y << 16), v[8 * i + 3] - __uint_as_float(hi.y & 0xffff0000u));
          lo.z = pk2(v[8 * i + 4] - __uint_as_float(hi.z << 16), v[8 * i + 5] - __uint_as_float(hi.z & 0xffff0000u));
          lo.w = pk2(v[8 * i + 6] - __uint_as_float(hi.w << 16), v[8 * i + 7] - __uint_as_float(hi.w & 0xffff0000u));
          *(uint4*)(XL + tok * DM + c) = lo;
        }
      }
    }
    if (tid < 64) lcnt[tid] = 0u;
    wait_vm0();
    __syncthreads();
    {
      const size_t trow = ((size_t)it * 32 + (lane & 31)) * DM;
      const u16* arow = (wid < 2 ? XB + trow : XL + trow - 1024);
      gemm32x128_ksplit(arow, WR2, 2048, 2048, LG, wid, lane);
    }
    const float br = BR[lane];
    const int lgc = (lane >> 5) * 64 + (lane & 31);
    for (int tt = 0; tt < 8; ++tt) {
      const int tl = wid * 8 + tt;
      const float s = sigmoidf_(LG[tl * 129 + lgc] + LG[tl * 129 + lgc + 32]);
      const float sb = s + br;
      int cnt = 0;
#pragma unroll
      for (int d = 1; d < 8; ++d) {
        const int src = (lane & ~7) | ((lane + d) & 7);
        const float o = __shfl(sb, src);
        cnt += (o > sb) || (o == sb && src < lane);
      }
      float gs = cnt < 2 ? sb : 0.f;
      gs += __shfl_xor(gs, 1); gs += __shfl_xor(gs, 2); gs += __shfl_xor(gs, 4);
      int grank = 0;
      const int myg = lane >> 3;
#pragma unroll
      for (int g = 0; g < 8; ++g) {
        const float og = __shfl(gs, g * 8);
        grank += (og > gs) || (og == gs && g < myg);
      }
      const float vsel = grank < 4 ? sb : -1e30f;
      int rank = 0;
#pragma unroll 8
      for (int j = 0; j < 64; ++j) {
        const float oj = __shfl(vsel, j);
        rank += (oj > vsel) || (oj == vsel && j < lane);
      }
      const bool sel = rank < 8;
      const float ssum = wave_sum(sel ? s : 0.f);
      if (sel) {
        const unsigned ls = atomicAdd(&lcnt[lane], 1u);
        pinfo[tl * 8 + rank] = (unsigned)lane | (ls << 8);
        pgw[tl * 8 + rank] = s / ssum * 2.5f;
      }
    }
    __syncthreads();
    if (tid < 64) lbase[tid] = atomicAdd(&CNT[tid], lcnt[tid]);
    __syncthreads();
    {
      const unsigned inf = pinfo[tid];
      const unsigned e = inf & 255u, ls = inf >> 8;
      const unsigned pid = (unsigned)(it * 32) * 8u + (unsigned)tid;
      LIST[(size_t)e * NTOK + lbase[e] + ls] = pid;
      LISTW[(size_t)e * NTOK + lbase[e] + ls] = pgw[tid];
    }
    __syncthreads();
  }
}

DEVI void build_tiles(const unsigned* CNT, int* tb, int* rowb, int* cnts) {
  const int tid = get_tid();
  if (tid < 64) {
    const int c = (int)CNT[tid];
    const int nb = (c + 127) >> 7;
    int st = nb, sr = c;
#pragma unroll
    for (int o = 1; o < 64; o <<= 1) {
      const int t2 = __shfl_up(st, o), r2 = __shfl_up(sr, o);
      if (tid >= o) { st += t2; sr += r2; }
    }
    tb[tid] = st - nb; rowb[tid] = sr - c; cnts[tid] = c;
    if (tid == 63) { tb[64] = st; rowb[64] = sr; cnts[64] = NTOK; tb[65] = st + (NTOK >> 7); }
  }
  __syncthreads();
}

DEVI void phase_gateup(const Params& p, int l, char* smem) {
  const int tid = get_tid(), lane = tid & 63, wid = tid >> 6, wr = wid >> 1, wc = wid & 1;
  const unsigned* CNT = (const unsigned*)(p.ws + OFF_CNT) + l * 128;
  const unsigned* LIST = (const unsigned*)(p.ws + OFF_LIST);
  const u8* X8 = (const u8*)(p.ws + OFF_XA);
  const u8* WGU = (const u8*)(p.ws + OFF_WGU);
  u8* H = (u8*)(p.ws + OFF_H);
  int* tb = (int*)(smem + 65536);
  int* rowb = tb + 72;
  int* cnts = rowb + 72;
  build_tiles(CNT, tb, rowb, cnts);
  const int ntiles = tb[65];
  int e_nxt = 0, e_cur = 0;
  auto load_rows = [&](int it, int (&tokr)[4]) {
    const int rbt = it >> 2;
    int e = e_nxt;
    while (tb[e + 1] <= rbt) ++e;
    e_nxt = e;
    const int rb = rbt - tb[e], cnt = cnts[e];
#pragma unroll
    for (int q = 0; q < 4; ++q) {
      int r = rb * 128 + (tid >> 3) + 32 * q;
      r = r < cnt ? r : cnt - 1;
      tokr[q] = e < 64 ? (int)(LIST[(size_t)e * NTOK + r] >> 3) : r;
    }
  };
  const int n_it = ntiles * 4, it_step = gridDim.x >> 3;
  const int it_beg = ((blockIdx.x & 7) * ((n_it + 7) >> 3)) + (blockIdx.x >> 3);
  const int it_end = min(n_it, ((blockIdx.x & 7) + 1) * ((n_it + 7) >> 3));
  int tokn[4] = {0, 0, 0, 0};
  if (it_beg < it_end) load_rows(it_beg, tokn);
  for (int it = it_beg; it < it_end; it += it_step) {
    const int rbt = it >> 2, nt = it & 3;
    int e = e_cur;
    while (tb[e + 1] <= rbt) ++e;
    e_cur = e;
    const int rb = rbt - tb[e], cnt = cnts[e];
    long aoff[4];
#pragma unroll
    for (int q = 0; q < 4; ++q) aoff[q] = (long)tokn[q] * DM;
    if (it + it_step < it_end) load_rows(it + it_step, tokn);
    f32x4 acc[4][4];
    gemm128_f8(X8, aoff, WGU + (size_t)e * 512 * DM, DM, nt * 128, DM, smem, acc);
    const int g64 = nt * 2 + wc;
#pragma unroll
    for (int m = 0; m < 4; ++m) {
      const int r = rb * 128 + wr * 64 + m * 16 + (lane & 15);
      if (r < cnt) {
        u8* hrow = H + (size_t)(rowb[e] + r) * EH + g64 * 32;
#pragma unroll
        for (int n = 0; n < 2; ++n) {
          float v[4];
#pragma unroll
          for (int q = 0; q < 4; ++q) {
            const float gt = acc[m][n][q] * (1.f / F8_SW), up = acc[m][n + 2][q] * (1.f / F8_SW);
            v[q] = gt / (1.f + __expf(-gt)) * up * F8_SH;
          }
          *(unsigned*)(hrow + n * 16 + 4 * (lane >> 4)) = pk4_f8c(v[0], v[1], v[2], v[3]);
        }
      }
    }
  }
}

DEVI void phase_down(const Params& p, int l, char* smem, int pflags = 0) {
  const int tid = get_tid(), lane = tid & 63, wid = tid >> 6, wr = wid >> 1, wc = wid & 1;
  const unsigned* CNT = (const unsigned*)(p.ws + OFF_CNT) + l * 128;
  const unsigned* LIST = (const unsigned*)(p.ws + OFF_LIST);
  const float* LISTW = (const float*)(p.ws + OFF_LISTW);
  const u8* WD = (const u8*)(p.ws + OFF_WD);
  const u8* H = (const u8*)(p.ws + OFF_H);
  u16* Y = (u16*)(p.ws + OFF_Y);
  u16* YSH = (u16*)(p.ws + OFF_YSH);
  int* tb = (int*)(smem + 65536);
  int* rowb = tb + 72;
  int* cnts = rowb + 72;
  build_tiles(CNT, tb, rowb, cnts);
  const int ntiles = tb[65];
  int e_nxt = 0, e_cur = 0;
  auto load_meta = [&](int it, unsigned (&pid)[4], float (&w)[4]) {
    const int rbt = it >> 1;
    int e = e_nxt;
    while (tb[e + 1] <= rbt) ++e;
    e_nxt = e;
    const int rb = rbt - tb[e], cnt = cnts[e];
#pragma unroll
    for (int m = 0; m < 4; ++m) {
      int r = rb * 128 + wr * 64 + m * 16 + (lane & 15);
      r = r < cnt ? r : cnt - 1;
      if (e < 64) { pid[m] = LIST[(size_t)e * NTOK + r]; w[m] = LISTW[(size_t)e * NTOK + r]; }
      else { pid[m] = (unsigned)r; w[m] = 1.f; }
    }
  };
  const int n_it = ntiles * 2, it_step = gridDim.x >> 3;
  const int it_beg = ((blockIdx.x & 7) * ((n_it + 7) >> 3)) + (blockIdx.x >> 3);
  const int it_end = min(n_it, ((blockIdx.x & 7) + 1) * ((n_it + 7) >> 3));
  unsigned pidn[4] = {0u, 0u, 0u, 0u};
  float wn[4] = {1.f, 1.f, 1.f, 1.f};
  if (it_beg < it_end) load_meta(it_beg, pidn, wn);
  for (int it = it_beg; it < it_end; it += it_step) {
    const int rbt = it >> 1, nh = it & 1;
    int e = e_cur;
    while (tb[e + 1] <= rbt) ++e;
    e_cur = e;
    const int rb = rbt - tb[e], cnt = cnts[e];
    long aoff[4];
#pragma unroll
    for (int q = 0; q < 4; ++q) aoff[q] = (long)(rowb[e] + rb * 128 + (tid >> 3) + 32 * q) * EH;
    u16* yrow[4];
    float wrow[4];
#pragma unroll
    for (int m = 0; m < 4; ++m) {
      const int r = rb * 128 + wr * 64 + m * 16 + (lane & 15);
      wrow[m] = wn[m];
      u16* dst = e < 64 ? Y + (size_t)pidn[m] * DM : YSH + (size_t)pidn[m] * DM;
      yrow[m] = (r < cnt && !(pflags & 32)) ? dst : (u16*)(p.ws + WS_NEED) + (size_t)(tid & 255) * DM;
    }
    if (it + it_step < it_end) load_meta(it + it_step, pidn, wn);
    gemm128_stream_f8<8>(H, aoff, WD + (size_t)e * DM * EH, EH, nh * 512, 4, EH, smem, [&](int tile, f32x4 (&acc)[4][4]) {
#pragma unroll
      for (int m = 0; m < 4; ++m) {
        {
          const float w = wrow[m] * (1.f / (F8_SW * F8_SH));
          const int col0 = nh * 512 + tile * 128 + wc * 64 + 16 * (lane >> 4);
          uint4 v0, v1;
          v0.x = pk2(acc[m][0][0] * w, acc[m][0][1] * w); v0.y = pk2(acc[m][0][2] * w, acc[m][0][3] * w);
          v0.z = pk2(acc[m][1][0] * w, acc[m][1][1] * w); v0.w = pk2(acc[m][1][2] * w, acc[m][1][3] * w);
          v1.x = pk2(acc[m][2][0] * w, acc[m][2][1] * w); v1.y = pk2(acc[m][2][2] * w, acc[m][2][3] * w);
          v1.z = pk2(acc[m][3][0] * w, acc[m][3][1] * w); v1.w = pk2(acc[m][3][2] * w, acc[m][3][3] * w);
          if (pflags & 64) {
            asm volatile("" ::"v"(v0.x), "v"(v0.y), "v"(v0.z), "v"(v0.w), "v"(v1.x), "v"(v1.y), "v"(v1.z), "v"(v1.w));
          } else {
            *(uint4*)(yrow[m] + col0) = v0;
            *(uint4*)(yrow[m] + col0 + 8) = v1;
          }
        }
      }
      return !(pflags & 64);
    });
  }
}

DEVI void phase_combine(const Params& p, int l, char* smem) {
  const int tid = get_tid(), lane = tid & 63, wid = tid >> 6;
  const u16* XBr = (const u16*)(p.ws + OFF_XB);
  const u16* XLr = (const u16*)(p.ws + OFF_XL);
  const u16* Y = (const u16*)(p.ws + OFF_Y);
  const u16* YSH = (const u16*)(p.ws + OFF_YSH);
  float* XO = l == NL - 1 ? p.out : (float*)(p.ws + OFF_XBUF);
  u16* XB = (u16*)(p.ws + OFF_XB);
  const float* g2 = p.in[20] + l * DM;
  const float* b2 = p.in[21] + l * DM;
  for (int it = blockIdx.x; it < NTOK / 4; it += gridDim.x) {
    const size_t tok = (size_t)it * 4 + wid;
    float v[16];
    uint4 yv[2][9];
    float4 xv[2][2];
#pragma unroll
    for (int i = 0; i < 2; ++i) {
      const int c = lane * 8 + 512 * i;
      {
        const uint4 xh = *(const uint4*)(XBr + tok * DM + c), xl = *(const uint4*)(XLr + tok * DM + c);
        xv[i][0] = make_float4(__uint_as_float(xh.x << 16) + __uint_as_float(xl.x << 16), __uint_as_float(xh.x & 0xffff0000u) + __uint_as_float(xl.x & 0xffff0000u),
                               __uint_as_float(xh.y << 16) + __uint_as_float(xl.y << 16), __uint_as_float(xh.y & 0xffff0000u) + __uint_as_float(xl.y & 0xffff0000u));
        xv[i][1] = make_float4(__uint_as_float(xh.z << 16) + __uint_as_float(xl.z << 16), __uint_as_float(xh.z & 0xffff0000u) + __uint_as_float(xl.z & 0xffff0000u),
                               __uint_as_float(xh.w << 16) + __uint_as_float(xl.w << 16), __uint_as_float(xh.w & 0xffff0000u) + __uint_as_float(xl.w & 0xffff0000u));
      }
#pragma unroll
      for (int k = 0; k < 8; ++k) yv[i][k] = *(const uint4*)(Y + (tok * 8 + k) * DM + c);
      yv[i][8] = *(const uint4*)(YSH + tok * DM + c);
    }
#pragma unroll
    for (int i = 0; i < 2; ++i) {
      float a[8] = {ALPHA * xv[i][0].x, ALPHA * xv[i][0].y, ALPHA * xv[i][0].z, ALPHA * xv[i][0].w,
                    ALPHA * xv[i][1].x, ALPHA * xv[i][1].y, ALPHA * xv[i][1].z, ALPHA * xv[i][1].w};
#pragma unroll
      for (int k = 0; k < 9; ++k) {
        const uint4 y = yv[i][k];
        a[0] += __uint_as_float(y.x << 16); a[1] += __uint_as_float(y.x & 0xffff0000u);
        a[2] += __uint_as_float(y.y << 16); a[3] += __uint_as_float(y.y & 0xffff0000u);
        a[4] += __uint_as_float(y.z << 16); a[5] += __uint_as_float(y.z & 0xffff0000u);
        a[6] += __uint_as_float(y.w << 16); a[7] += __uint_as_float(y.w & 0xffff0000u);
      }
#pragma unroll
      for (int j = 0; j < 8; ++j) v[8 * i + j] = a[j];
    }
    ln_row8(v, g2, b2, lane);
#pragma unroll
    for (int i = 0; i < 2; ++i) {
      const int c = lane * 8 + 512 * i;
      *(float4*)(XO + tok * DM + c) = make_float4(v[8 * i], v[8 * i + 1], v[8 * i + 2], v[8 * i + 3]);
      *(float4*)(XO + tok * DM + c + 4) = make_float4(v[8 * i + 4], v[8 * i + 5], v[8 * i + 6], v[8 * i + 7]);
      if (l < NL - 1) {
        uint4 o;
        o.x = pk2(v[8 * i], v[8 * i + 1]); o.y = pk2(v[8 * i + 2], v[8 * i + 3]);
        o.z = pk2(v[8 * i + 4], v[8 * i + 5]); o.w = pk2(v[8 * i + 6], v[8 * i + 7]);
        *(uint4*)(XB + tok * DM + c) = o;
      }
    }
  }
}

constexpr int NPL = 10;
constexpr int NPHASE = 1 + NPL * NL;
constexpr int SMEM_BYTES = 66816;

#if MEGA
#define RUN_PHASE(S, CALL)                                              \
  {                                                                     \
    const int nrep_ = (pdup == (S)) ? 2 : 1;                            \
    for (int dup = 0; dup < nrep_; ++dup) {                             \
      Params p = pin;                                                   \
      asm volatile("" : "+s"(p.ws));   \
      CALL;                                                             \
      xcd_barrier(xb);                                                  \
    }                                                                   \
  }

__global__ void __launch_bounds__(256, 2) fwd_kernel(Params pin, int pdup, int psub) {
  __shared__ __attribute__((aligned(16))) char smem[SMEM_BYTES];
  volatile LAS unsigned* st = (volatile LAS unsigned*)(smem + 66576);
  if (threadIdx.x == 0) { st[0] = 0u; st[1] = 0u; }
  __syncthreads();
  XcdBarrier xb = xcd_barrier_post((unsigned*)(pin.ws + OFF_BAR), st);
  {
    const int nrep_ = (pdup == 10) ? 2 : 1;
    for (int dup = 0; dup < nrep_; ++dup) {
      Params p = pin;
      asm volatile("" : "+s"(p.ws));
      phase_prep(p, smem);
      if (pdup == 0x7fffffff) cg::this_grid().sync();
      xcd_barrier(xb);
    }
  }
#pragma unroll 1
  for (int l = 0; l < NL; ++l) {
    RUN_PHASE(0, phase_inproj(p, l, smem))
    RUN_PHASE(2, phase_s3a(p, l + 16 * dup, smem, psub))
    RUN_PHASE(3, phase_s3b(p, l + 16 * dup, smem, psub))
    RUN_PHASE(4, phase_outproj(p, l, smem))
    RUN_PHASE(5, phase_ln1_router(p, l, smem, dup))
    RUN_PHASE(7, phase_gateup(p, l, smem))
    RUN_PHASE(8, phase_down(p, l, smem, dup ? psub : 0))
    RUN_PHASE(9, phase_combine(p, l, smem))
  }
}
#endif

extern "C" void kernel_launch(void* const* d_in, const int* in_sizes, int n_in, void* d_out, int out_size, void* d_ws,
                              size_t ws_size, hipStream_t stream) {
  if (ws_size < WS_NEED) fprintf(stderr, "workspace too small: %zu < %zu\n", ws_size, (size_t)WS_NEED);
  Params p{};
  for (int i = 0; i < 22; ++i) p.in[i] = (const float*)d_in[i];
  p.out = (float*)d_out;
  p.ws = (char*)d_ws;
#if MEGA
  static int grid_blocks = 0;
  if (!grid_blocks) {
    int dev = 0, cus = 0, per_cu = 0;
    (void)hipGetDevice(&dev);
    (void)hipDeviceGetAttribute(&cus, hipDeviceAttributeMultiprocessorCount, dev);
    (void)hipOccupancyMaxActiveBlocksPerMultiprocessor(&per_cu, fwd_kernel, 256, 0);
    if (per_cu > 2) per_cu = 2;
    if (per_cu < 1) per_cu = 1;
    grid_blocks = cus * per_cu;
    if (grid_blocks > MAXGRID) grid_blocks = MAXGRID;
  }
  (void)hipMemsetAsync((char*)d_ws + OFF_BAR, 0, BAR_BYTES, stream);
  int pdup = PROBE_DUP, psub = PROBE_SUB;
  void* args[] = {&p, &pdup, &psub};
  hipError_t e = hipLaunchCooperativeKernel((void*)fwd_kernel, dim3(grid_blocks), dim3(256), args, 0, stream);
  if (e != hipSuccess) fprintf(stderr, "cooperative launch failed: %s (grid %d)\n", hipGetErrorString(e), grid_blocks);
#endif
}
```

```cpp
#include <hip/hip_runtime.h>
#include <hip/hip_cooperative_groups.h>
#include <cstdio>
#include <cstdint>
namespace cg = cooperative_groups;

#ifndef MEGA
#define MEGA 1
#endif
#define PROBE_DUP -1
#define PROBE_SUB 0

typedef __attribute__((ext_vector_type(8))) __bf16 bf8;
typedef __attribute__((ext_vector_type(4))) __bf16 bf4;
typedef __attribute__((ext_vector_type(4))) float f32x4;
typedef __attribute__((ext_vector_type(16))) float f32x16;
typedef unsigned short u16;
typedef unsigned long long u64;

#define DEVI __device__ __forceinline__

constexpr int B_ = 8, T_ = 2048, DM = 1024, NTOK = B_ * T_, NL = 4;
constexpr int NIN = 2778, NPAD = 2816, NCH = 44;
constexpr int NE = 64, EH = 256;
constexpr float ALPHA = 1.681792830507429f;
constexpr float LOG2E = 1.4426950408889634f;
constexpr float QSCALE = 0.125f * LOG2E;
constexpr float LN_EPS = 1e-5f;

constexpr int CH_FOXQ = 0, CH_FOXK = 4, CH_FOXV = 8, CH_NSAQ = 12, CH_NSAKC = 18, CH_NSAVC = 20, CH_NSAKS = 22,
              CH_NSAVS = 24, CH_NSAKW = 26, CH_NSAVW = 28, CH_DSAQ = 30, CH_DSAK = 36, CH_DSAV = 37, CH_IDXQ = 38,
              CH_IDXK = 42, CH_MISC = 43;
constexpr size_t CHSZ = (size_t)B_ * T_ * 64;

constexpr size_t al256(size_t x) { return (x + 255) & ~(size_t)255; }
constexpr size_t OFF_WIN = 0;
constexpr size_t OFF_WO = OFF_WIN + al256((size_t)NL * NPAD * DM * 2);
constexpr size_t OFF_WC1 = OFF_WO + al256((size_t)NL * DM * DM * 2);
constexpr size_t OFF_CB = OFF_WC1 + al256((size_t)NL * 2 * 128 * 2048 * 2);
constexpr size_t OFF_ROPE = OFF_CB + al256((size_t)NL * 2 * 128 * 4);
constexpr size_t OFF_WGU = OFF_ROPE + al256((size_t)T_ * 32 * 8);
constexpr size_t OFF_WD = OFF_WGU + al256((size_t)65 * 512 * DM * 2);
constexpr size_t OFF_XB = OFF_WD + al256((size_t)65 * DM * EH * 2);
constexpr size_t OFF_XA = OFF_XB + al256((size_t)NTOK * DM * 2);
constexpr size_t OFF_XBUF = OFF_XA + al256((size_t)NTOK * DM * 4);
constexpr size_t OFF_O = OFF_XBUF + al256((size_t)NTOK * DM * 4);
constexpr size_t OFF_CNT = OFF_O + al256((size_t)NTOK * DM * 2);
constexpr size_t OFF_LIST = OFF_CNT + al256((size_t)NL * 128 * 4);
constexpr size_t OFF_PAIRW = OFF_LIST + al256((size_t)NE * NTOK * 4);
constexpr size_t OFF_LISTW = OFF_PAIRW + al256((size_t)NTOK * 8 * 4);
constexpr size_t OFF_XL = OFF_LISTW + al256((size_t)NE * NTOK * 4);
constexpr size_t OFF_WR2 = OFF_XL + al256((size_t)NTOK * DM * 2);
constexpr size_t OFF_CBP = OFF_WR2 + al256((size_t)NL * 128 * 2048 * 2);
constexpr size_t OFF_BAR = OFF_CBP + al256((size_t)NL * 2 * 8 * 128 * 4);
constexpr size_t BAR_BYTES = 16384;
constexpr size_t OFF_SCR = OFF_BAR + BAR_BYTES;
constexpr size_t OFF_CH = OFF_SCR;
constexpr size_t OFF_MISC = OFF_CH + al256((size_t)43 * CHSZ * 2);
constexpr size_t OFF_CL = OFF_MISC + al256((size_t)NTOK * 32 * 4);
constexpr size_t OFF_KCMP = OFF_CL + al256((size_t)B_ * 4 * T_ * 4);
constexpr size_t OFF_VCMPT = OFF_KCMP + al256((size_t)B_ * 2 * 128 * 64 * 2);
constexpr size_t OFF_OCMP = OFF_VCMPT + al256((size_t)B_ * 2 * 64 * 128 * 2);
constexpr size_t OFF_SELM = OFF_OCMP + al256((size_t)NTOK * 384 * 4);
constexpr size_t OFF_DMASK = OFF_SELM + al256((size_t)B_ * 2 * T_ * 4);
constexpr size_t OFF_DSCR = OFF_DMASK + al256((size_t)NTOK * 32 * 8);
constexpr int MAXGRID = 768;
constexpr size_t ATT_END = OFF_DSCR + (size_t)MAXGRID * 32 * 2048 * 4;
constexpr size_t OFF_H = OFF_SCR;
constexpr size_t OFF_Y = OFF_H + al256((size_t)(NTOK * 9 + 256) * EH * 2);
constexpr size_t OFF_YSH = OFF_Y + al256((size_t)NTOK * 8 * DM * 2);
constexpr size_t MOE_END = OFF_YSH + al256((size_t)NTOK * DM * 2);
constexpr size_t WS_NEED = ATT_END > MOE_END ? ATT_END : MOE_END;

struct Params {
  const float* in[22];
  float* out;
  char* ws;
};

DEVI int get_tid() { int t = threadIdx.x; asm volatile("" : "+v"(t)); return t; }
DEVI float bf2f(u16 v) { return __uint_as_float(((unsigned)v) << 16); }
DEVI u16 f2bf(float f) { __bf16 b = (__bf16)f; return __builtin_bit_cast(u16, b); }
DEVI unsigned pk2(float a, float b) { return (unsigned)f2bf(a) | ((unsigned)f2bf(b) << 16); }
DEVI uint2 pk4(float a, float b, float c, float d) { return make_uint2(pk2(a, b), pk2(c, d)); }
DEVI float fexp2(float x) { return __builtin_amdgcn_exp2f(x); }
DEVI float sigmoidf_(float x) { return 1.f / (1.f + __expf(-x)); }
DEVI float wave_sum(float v) {
#pragma unroll
  for (int o = 32; o > 0; o >>= 1) v += __shfl_xor(v, o);
  return v;
}
DEVI void glds16(const void* g, void* l) {
  __builtin_amdgcn_global_load_lds((const unsigned*)g, (unsigned*)l, 16, 0, 0);
}
DEVI void wait_vm0() { asm volatile("s_waitcnt vmcnt(0)" ::: "memory"); }
DEVI float ld_sc1(const float* p) { return __hip_atomic_load(p, __ATOMIC_RELAXED, __HIP_MEMORY_SCOPE_AGENT); }

#define XB_TMO      128
#define XB_XCNT(j)  (256  + 64 * (j))
#define XB_XSUB(j)  (1280 + 64 * (j))
#define XB_XGEN(j)  (2304 + 64 * (j))
#define XB_TOP      3328
#define XB_TOPGEN   3392
#define XB_WCTR     3456
#define XB_SPIN_CAP (1u << 22)
#define LAS __attribute__((address_space(3)))
DEVI unsigned xb_ld(unsigned* p) { return __hip_atomic_load(p, __ATOMIC_RELAXED, __HIP_MEMORY_SCOPE_AGENT); }
DEVI unsigned xb_add(unsigned* p, unsigned v) { return __hip_atomic_fetch_add(p, v, __ATOMIC_RELAXED, __HIP_MEMORY_SCOPE_AGENT); }
DEVI unsigned xb_xcc_id() { return (unsigned)__builtin_amdgcn_s_getreg((3 << 11) | 20) & 0xFu; }
#define XB_SPIN(cond, bar) do { unsigned _sp = 0; while (cond) { __builtin_amdgcn_s_sleep(1); \
    if ((++_sp & 255u) == 0u) { if (xb_ld(&(bar)[XB_TMO])) break; if (_sp > XB_SPIN_CAP) { atomicAdd(&(bar)[XB_TMO], 1u); break; } } } } while (0)
struct XcdBarrier { unsigned* bar; unsigned x; volatile LAS unsigned* st; };
DEVI XcdBarrier xcd_barrier_post(unsigned* bar, volatile LAS unsigned* st) {
  XcdBarrier b; b.bar = bar; b.x = xb_xcc_id(); b.st = st;
  if (threadIdx.x == 0) (void)xb_add(&bar[XB_XCNT(b.x)], 1u);
  return b;
}
DEVI void xcd_barrier_complete(unsigned* bar, unsigned x, unsigned& nloc, unsigned& nx) {
  const unsigned G = gridDim.x * gridDim.y * gridDim.z;
  unsigned sum, cnt, mine, sp = 0u;
  for (;;) {
    sum = 0u; cnt = 0u; mine = 0u;
#pragma unroll
    for (unsigned j = 0; j < 16; ++j) { const unsigned c = xb_ld(&bar[XB_XCNT(j)]); sum += c; cnt += (c > 0u) ? 1u : 0u; mine = (j == x) ? c : mine; }
    if (sum == G) break;
    __builtin_amdgcn_s_sleep(1);
    if ((++sp & 255u) == 0u) { if (xb_ld(&bar[XB_TMO])) break; if (sp > XB_SPIN_CAP) { atomicAdd(&bar[XB_TMO], 1u); break; } }
  }
  nloc = mine > 0u ? mine : 1u; nx = cnt > 0u ? cnt : 1u;
}
DEVI void xcd_barrier(const XcdBarrier& b) {
  asm volatile("s_waitcnt vmcnt(0)" ::: "memory");
  __syncthreads();
  if (threadIdx.x == 0) {
    unsigned* bar = b.bar;
    asm volatile("" : "+s"(bar));
    __builtin_amdgcn_s_waitcnt(0);
    unsigned nloc = b.st[0], nx = b.st[1];
    if (nloc == 0u) { xcd_barrier_complete(bar, b.x, nloc, nx); b.st[0] = nloc; b.st[1] = nx; }
    const unsigned old = xb_add(&bar[XB_XSUB(b.x)], 1u);
    const unsigned gen = old / nloc;
    if (old + 1u == (gen + 1u) * nloc) {
      __builtin_amdgcn_fence(__ATOMIC_RELEASE, "agent");
      asm volatile("s_waitcnt vmcnt(0)" ::: "memory");
      const unsigned og = xb_add(&bar[XB_TOP], 1u);
      const unsigned tg = og / nx;
      if (og + 1u == (tg + 1u) * nx) xb_add(&bar[XB_TOPGEN], 1u);
      else XB_SPIN(xb_ld(&bar[XB_TOPGEN]) == tg, bar);
      __builtin_amdgcn_fence(__ATOMIC_ACQUIRE, "agent");
      xb_add(&bar[XB_XGEN(b.x)], 1u);
      asm volatile("s_waitcnt vmcnt(0)" ::: "memory");
    } else {
      XB_SPIN(xb_ld(&bar[XB_XGEN(b.x)]) == gen, bar);
      __builtin_amdgcn_fence(__ATOMIC_ACQUIRE, "agent");
      asm volatile("s_waitcnt vmcnt(0)" ::: "memory");
    }
  }
  __syncthreads();
}
DEVI int next_item(unsigned* ctr, char* smem) {
  volatile int* slot = (volatile int*)(smem + 66560);
  __syncthreads();
  if (threadIdx.x == 0) *slot = (int)xb_add(ctr, 1u);
  __syncthreads();
  return *slot;
}

DEVI void gemm128(const u16* __restrict__ A, const long (&aoff)[4], const u16* __restrict__ Bt, long ldb, int n0,
                  int K, char* smem, f32x4 (&acc)[4][4], int ksplit = 1 << 30, long kjump = 0) {
  const int tid = get_tid(), lane = tid & 63, wid = tid >> 6, wr = wid >> 1, wc = wid & 1;
#pragma unroll
  for (int m = 0; m < 4; ++m)
#pragma unroll
    for (int n = 0; n < 4; ++n) acc[m][n] = (f32x4){0.f, 0.f, 0.f, 0.f};
  const int srow = tid >> 3, scp = tid & 7;
  long boff[4];
  int sc[4];
#pragma unroll
  for (int i = 0; i < 4; ++i) {
    const int row = srow + 32 * i;
    sc[i] = (scp ^ ((row >> 1) & 7)) * 8;
    boff[i] = (long)(n0 + row) * ldb;
  }
  const int sw = (lane >> 1) & 7;
  __syncthreads();
#pragma unroll
  for (int i = 0; i < 4; ++i) {
    glds16(A + aoff[i] + sc[i], smem + tid * 16 + i * 4096);
    glds16(Bt + boff[i] + sc[i], smem + 16384 + tid * 16 + i * 4096);
  }
  int cur = 0;
  for (int kt = 0; kt < K; kt += 64) {
    wait_vm0();
    __syncthreads();
    char* SA = smem + cur * 32768;
    char* SB = SA + 16384;
    if (kt + 64 < K) {
      char* NA = smem + (cur ^ 1) * 32768;
#pragma unroll
      for (int i = 0; i < 4; ++i) {
        glds16(A + aoff[i] + kt + 64 + ((kt + 64 >= ksplit) ? kjump : 0) + sc[i], NA + tid * 16 + i * 4096);
        glds16(Bt + boff[i] + kt + 64 + sc[i], NA + 16384 + tid * 16 + i * 4096);
      }
    }
#pragma unroll
    for (int ks = 0; ks < 2; ++ks) {
      bf8 af[4], bfr[4];
      const int c = ((ks * 4 + (lane >> 4)) ^ sw) << 4;
#pragma unroll
      for (int m = 0; m < 4; ++m) af[m] = *(const bf8*)(SA + (wr * 64 + m * 16 + (lane & 15)) * 128 + c);
#pragma unroll
      for (int n = 0; n < 4; ++n) bfr[n] = *(const bf8*)(SB + (wc * 64 + n * 16 + (lane & 15)) * 128 + c);
      __builtin_amdgcn_s_setprio(1);
#pragma unroll
      for (int m = 0; m < 4; ++m)
#pragma unroll
        for (int n = 0; n < 4; ++n) acc[m][n] = __builtin_amdgcn_mfma_f32_16x16x32_bf16(bfr[n], af[m], acc[m][n], 0, 0, 0);
      __builtin_amdgcn_s_setprio(0);
    }
    cur ^= 1;
  }
}

template <int EPI_ST, class Epi>
DEVI void gemm128_stream(const u16* __restrict__ A, const long (&aoff)[4], const u16* __restrict__ Bt, long ldb, int n0,
                         int ntiles, int K, char* smem, Epi epi) {
  const int tid = get_tid(), lane = tid & 63, wid = tid >> 6, wr = wid >> 1, wc = wid & 1;
  f32x4 acc[4][4];
#pragma unroll
  for (int m = 0; m < 4; ++m)
#pragma unroll
    for (int n = 0; n < 4; ++n) acc[m][n] = (f32x4){0.f, 0.f, 0.f, 0.f};
  const int srow = tid >> 3, scp = tid & 7;
  long boff[4];
  int sc[4];
#pragma unroll
  for (int i = 0; i < 4; ++i) {
    const int row = srow + 32 * i;
    sc[i] = (scp ^ ((row >> 1) & 7)) * 8;
    boff[i] = (long)(n0 + row) * ldb;
  }
  const int sw = (lane >> 1) & 7;
  const int ksteps = K >> 6, total = ntiles * ksteps;
  __syncthreads();
#pragma unroll
  for (int i = 0; i < 4; ++i) {
    glds16(A + aoff[i] + sc[i], smem + tid * 16 + i * 4096);
    glds16(Bt + boff[i] + sc[i], smem + 16384 + tid * 16 + i * 4096);
  }
  int cur = 0, ks = 0, tile = 0;
  bool after_epi = false;
  for (int st = 0; st < total; ++st) {
    if (EPI_ST > 0 && after_epi) {
      asm volatile("s_waitcnt vmcnt(%0)" ::"n"(EPI_ST) : "memory");
      asm volatile("s_waitcnt lgkmcnt(0)" ::: "memory");
      __builtin_amdgcn_s_barrier();
    } else {
      wait_vm0();
      __syncthreads();
    }
    after_epi = false;
    char* SA = smem + cur * 32768;
    char* SB = SA + 16384;
    if (st + 1 < total) {
      int nks = ks + 1, ntile = tile;
      if (nks == ksteps) { nks = 0; ++ntile; }
      char* NA = smem + (cur ^ 1) * 32768;
      const long bo = (long)ntile * 128 * ldb + nks * 64;
#pragma unroll
      for (int i = 0; i < 4; ++i) {
        glds16(A + aoff[i] + nks * 64 + sc[i], NA + tid * 16 + i * 4096);
        glds16(Bt + boff[i] + bo + sc[i], NA + 16384 + tid * 16 + i * 4096);
      }
    }
#pragma unroll
    for (int k2 = 0; k2 < 2; ++k2) {
      bf8 af[4], bfr[4];
      const int c = ((k2 * 4 + (lane >> 4)) ^ sw) << 4;
#pragma unroll
      for (int m = 0; m < 4; ++m) af[m] = *(const bf8*)(SA + (wr * 64 + m * 16 + (lane & 15)) * 128 + c);
#pragma unroll
      for (int n = 0; n < 4; ++n) bfr[n] = *(const bf8*)(SB + (wc * 64 + n * 16 + (lane & 15)) * 128 + c);
      __builtin_amdgcn_s_setprio(1);
#pragma unroll
      for (int m = 0; m < 4; ++m)
#pragma unroll
        for (int n = 0; n < 4; ++n) acc[m][n] = __builtin_amdgcn_mfma_f32_16x16x32_bf16(bfr[n], af[m], acc[m][n], 0, 0, 0);
      __builtin_amdgcn_s_setprio(0);
    }
    cur ^= 1;
    if (++ks == ksteps) {
      after_epi = epi(tile, acc);
#pragma unroll
      for (int m = 0; m < 4; ++m)
#pragma unroll
        for (int n = 0; n < 4; ++n) acc[m][n] = (f32x4){0.f, 0.f, 0.f, 0.f};
      ks = 0;
      ++tile;
    }
  }
}

typedef unsigned char u8;
constexpr float F8_SW = 32.f;
constexpr float F8_SH = 4.f;
constexpr float F8_SY = 64.f;
DEVI unsigned pk4_f8(float a, float b, float c, float d) {
  int w = 0;
  w = __builtin_amdgcn_cvt_pk_fp8_f32(a, b, w, false);
  w = __builtin_amdgcn_cvt_pk_fp8_f32(c, d, w, true);
  return (unsigned)w;
}
DEVI unsigned pk4_f8c(float a, float b, float c, float d) {
  return pk4_f8(__builtin_amdgcn_fmed3f(a, -448.f, 448.f), __builtin_amdgcn_fmed3f(b, -448.f, 448.f),
                __builtin_amdgcn_fmed3f(c, -448.f, 448.f), __builtin_amdgcn_fmed3f(d, -448.f, 448.f));
}
DEVI void gemm128_f8(const u8* __restrict__ A, const long (&aoff)[4], const u8* __restrict__ Bt, long ldb, int n0,
                     int K, char* smem, f32x4 (&acc)[4][4]) {
  const int tid = get_tid(), lane = tid & 63, wid = tid >> 6, wr = wid >> 1, wc = wid & 1;
#pragma unroll
  for (int m = 0; m < 4; ++m)
#pragma unroll
    for (int n = 0; n < 4; ++n) acc[m][n] = (f32x4){0.f, 0.f, 0.f, 0.f};
  const int srow = tid >> 3, scp = tid & 7;
  long boff[4];
  int sc[4];
#pragma unroll
  for (int i = 0; i < 4; ++i) {
    const int row = srow + 32 * i;
    sc[i] = (scp ^ ((row >> 1) & 7)) * 16;
    boff[i] = (long)(n0 + row) * ldb;
  }
  const int sw = (lane >> 1) & 7, g = lane >> 4;
  __syncthreads();
#pragma unroll
  for (int i = 0; i < 4; ++i) {
    glds16(A + aoff[i] + sc[i], smem + tid * 16 + i * 4096);
    glds16(Bt + boff[i] + sc[i], smem + 16384 + tid * 16 + i * 4096);
  }
  int cur = 0;
  for (int kt = 0; kt < K; kt += 128) {
    wait_vm0();
    __syncthreads();
    char* SA = smem + cur * 32768;
    char* SB = SA + 16384;
    if (kt + 128 < K) {
      char* NA = smem + (cur ^ 1) * 32768;
#pragma unroll
      for (int i = 0; i < 4; ++i) {
        glds16(A + aoff[i] + kt + 128 + sc[i], NA + tid * 16 + i * 4096);
        glds16(Bt + boff[i] + kt + 128 + sc[i], NA + 16384 + tid * 16 + i * 4096);
      }
    }
#pragma unroll
    for (int ks = 0; ks < 4; ++ks) {
      long af[4], bfr[4];
      const int c = (((2 * ks + (g >> 1)) ^ sw) << 4) + 8 * (g & 1);
#pragma unroll
      for (int m = 0; m < 4; ++m) af[m] = *(const long*)(SA + (wr * 64 + m * 16 + (lane & 15)) * 128 + c);
#pragma unroll
      for (int n = 0; n < 4; ++n) bfr[n] = *(const long*)(SB + (wc * 64 + n * 16 + (lane & 15)) * 128 + c);
      __builtin_amdgcn_s_setprio(1);
#pragma unroll
      for (int m = 0; m < 4; ++m)
#pragma unroll
        for (int n = 0; n < 4; ++n) acc[m][n] = __builtin_amdgcn_mfma_f32_16x16x32_fp8_fp8(bfr[n], af[m], acc[m][n], 0, 0, 0);
      __builtin_amdgcn_s_setprio(0);
    }
    cur ^= 1;
  }
}

template <int EPI_ST, class Epi>
DEVI void gemm128_stream_f8(const u8* __restrict__ A, const long (&aoff)[4], const u8* __restrict__ Bt, long ldb, int n0,
                            int ntiles, int K, char* smem, Epi epi) {
  const int tid = get_tid(), lane = tid & 63, wid = tid >> 6, wr = wid >> 1, wc = wid & 1;
  f32x4 acc[4][4];
#pragma unroll
  for (int m = 0; m < 4; ++m)
#pragma unroll
    for (int n = 0; n < 4; ++n) acc[m][n] = (f32x4){0.f, 0.f, 0.f, 0.f};
  const int srow = tid >> 3, scp = tid & 7;
  long boff[4];
  int sc[4];
#pragma unroll
  for (int i = 0; i < 4; ++i) {
    const int row = srow + 32 * i;
    sc[i] = (scp ^ ((row >> 1) & 7)) * 16;
    boff[i] = (long)(n0 + row) * ldb;
  }
  const int sw = (lane >> 1) & 7, g = lane >> 4;
  const int ksteps = K >> 7, total = ntiles * ksteps;
  __syncthreads();
#pragma unroll
  for (int i = 0; i < 4; ++i) {
    glds16(A + aoff[i] + sc[i], smem + tid * 16 + i * 4096);
    glds16(Bt + boff[i] + sc[i], smem + 16384 + tid * 16 + i * 4096);
  }
  int cur = 0, ks = 0, tile = 0;
  bool after_epi = false;
  for (int st = 0; st < total; ++st) {
    if (EPI_ST > 0 && after_epi) {
      asm volatile("s_waitcnt vmcnt(%0)" ::"n"(EPI_ST) : "memory");
      asm volatile("s_waitcnt lgkmcnt(0)" ::: "memory");
      __builtin_amdgcn_s_barrier();
    } else {
      wait_vm0();
      __syncthreads();
    }
    after_epi = false;
    char* SA = smem + cur * 32768;
    char* SB = SA + 16384;
    if (st + 1 < total) {
      int nks = ks + 1, ntile = tile;
      if (nks == ksteps) { nks = 0; ++ntile; }
      char* NA = smem + (cur ^ 1) * 32768;
      const long bo = (long)ntile * 128 * ldb + nks * 128;
#pragma unroll
      for (int i = 0; i < 4; ++i) {
        glds16(A + aoff[i] + nks * 128 + sc[i], NA + tid * 16 + i * 4096);
        glds16(Bt + boff[i] + bo + sc[i], NA + 16384 + tid * 16 + i * 4096);
      }
    }
#pragma unroll
    for (int k2 = 0; k2 < 4; ++k2) {
      long af[4], bfr[4];
      const int c = (((2 * k2 + (g >> 1)) ^ sw) << 4) + 8 * (g & 1);
#pragma unroll
      for (int m = 0; m < 4; ++m) af[m] = *(const long*)(SA + (wr * 64 + m * 16 + (lane & 15)) * 128 + c);
#pragma unroll
      for (int n = 0; n < 4; ++n) bfr[n] = *(const long*)(SB + (wc * 64 + n * 16 + (lane & 15)) * 128 + c);
      __builtin_amdgcn_s_setprio(1);
#pragma unroll
      for (int m = 0; m < 4; ++m)
#pragma unroll
        for (int n = 0; n < 4; ++n) acc[m][n] = __builtin_amdgcn_mfma_f32_16x16x32_fp8_fp8(bfr[n], af[m], acc[m][n], 0, 0, 0);
      __builtin_amdgcn_s_setprio(0);
    }
    cur ^= 1;
    if (++ks == ksteps) {
      after_epi = epi(tile, acc);
#pragma unroll
      for (int m = 0; m < 4; ++m)
#pragma unroll
        for (int n = 0; n < 4; ++n) acc[m][n] = (f32x4){0.f, 0.f, 0.f, 0.f};
      ks = 0;
      ++tile;
    }
  }
}

template <class CP>
DEVI void cvt_tile(CP colptr, int ld, int k0, u16* __restrict__ dst, int dstK, int nrow0, char* smem) {
  float* tile = (float*)smem;
  const int tid = get_tid(), n = tid & 31, kk = tid >> 5;
  const float* cp = colptr(nrow0 + n);
#pragma unroll
  for (int i = 0; i < 8; ++i) {
    const int k = kk + 8 * i;
    tile[n * 65 + k] = cp ? cp[(long)(k0 + k) * ld] : 0.f;
  }
  __syncthreads();
  const int r = tid >> 3, c8 = (tid & 7) * 8;
  const float* tp = tile + r * 65 + c8;
  uint4 v;
  v.x = pk2(tp[0], tp[1]); v.y = pk2(tp[2], tp[3]); v.z = pk2(tp[4], tp[5]); v.w = pk2(tp[6], tp[7]);
  *(uint4*)(dst + (long)(nrow0 + r) * dstK + k0 + c8) = v;
  __syncthreads();
}

template <class PERM>
DEVI void cvt64(const float* __restrict__ srcA, const float* __restrict__ srcB, int ld, int k0, u16* __restrict__ dst, int dstK,
                int nrow0, PERM perm, char* smem) {
  float* tile = (float*)smem;
  const int tid = get_tid();
  {
    const int c4 = (tid & 15) * 4, kr = tid >> 4;
    const float* sp = c4 < 32 ? srcA + c4 : srcB + (c4 - 32);
#pragma unroll
    for (int i = 0; i < 4; ++i) {
      const int k = kr + 16 * i;
      const float4 v = *(const float4*)(sp + (long)(k0 + k) * ld);
      float* tp = tile + k * 65 + c4;
      tp[0] = v.x; tp[1] = v.y; tp[2] = v.z; tp[3] = v.w;
    }
  }
  __syncthreads();
  {
    const int r = tid >> 2, kc = (tid & 3) * 16;
    const float* tp = tile + kc * 65 + perm(r);
    uint4 v0, v1;
    v0.x = pk2(tp[0], tp[65]); v0.y = pk2(tp[130], tp[195]); v0.z = pk2(tp[260], tp[325]); v0.w = pk2(tp[390], tp[455]);
    v1.x = pk2(tp[520], tp[585]); v1.y = pk2(tp[650], tp[715]); v1.z = pk2(tp[780], tp[845]); v1.w = pk2(tp[910], tp[975]);
    u16* dp = dst + (long)(nrow0 + r) * dstK + k0 + kc;
    *(uint4*)dp = v0;
    *(uint4*)(dp + 8) = v1;
  }
  __syncthreads();
}
DEVI int perm16(int c) { return 16 * ((c >> 2) & 3) + 4 * (c >> 4) + (c & 3); }
struct CvtJob { const float* sp; long rstride; u8* dp; int permflag; };
DEVI void cvt64_load(const CvtJob& j, float4 (&v)[4]) {
#pragma unroll
  for (int i = 0; i < 4; ++i) v[i] = *(const float4*)(j.sp + (long)(16 * i) * j.rstride);
}
DEVI void lds_barrier() {
  asm volatile("s_waitcnt lgkmcnt(0)" ::: "memory");
  __builtin_amdgcn_s_barrier();
}
DEVI void cvt64_store(const CvtJob& j, const float4 (&v)[4], char* smem) {
  float* tile = (float*)smem;
  const int tid = get_tid();
  {
    const int c4 = (tid & 15) * 4, kr = tid >> 4;
#pragma unroll
    for (int i = 0; i < 4; ++i) {
      float* tp = tile + (kr + 16 * i) * 65 + c4;
      tp[0] = v[i].x; tp[1] = v[i].y; tp[2] = v[i].z; tp[3] = v[i].w;
    }
  }
  lds_barrier();
  {
    const int r = tid >> 2, kc = (tid & 3) * 16;
    const float* tp = tile + kc * 65 + (j.permflag ? perm16(r) : r);
    uint4 v0;
    v0.x = pk4_f8(tp[0] * F8_SW, tp[65] * F8_SW, tp[130] * F8_SW, tp[195] * F8_SW);
    v0.y = pk4_f8(tp[260] * F8_SW, tp[325] * F8_SW, tp[390] * F8_SW, tp[455] * F8_SW);
    v0.z = pk4_f8(tp[520] * F8_SW, tp[585] * F8_SW, tp[650] * F8_SW, tp[715] * F8_SW);
    v0.w = pk4_f8(tp[780] * F8_SW, tp[845] * F8_SW, tp[910] * F8_SW, tp[975] * F8_SW);
    *(uint4*)j.dp = v0;
  }
  lds_barrier();
}
DEVI CvtJob cvt64_job(const float* srcA, const float* srcB, int ld, int k0, u8* dst, int dstK, int nrow0, int permflag, int tid) {
  CvtJob j;
  const int c4 = (tid & 15) * 4, kr = tid >> 4;
  j.sp = (c4 < 32 ? srcA + c4 : srcB + (c4 - 32)) + (long)(k0 + kr) * ld;
  j.rstride = ld;
  j.dp = dst + (long)(nrow0 + (tid >> 2)) * dstK + k0 + (tid & 3) * 16;
  j.permflag = permflag;
  return j;
}

DEVI int win_srccol(int np) {
  const int j = np >> 6, d = np & 63;
  if (j < 12) return 64 * j + d;
  if (j < 30) return 772 + 64 * (j - 12) + d;
  if (j < 43) return 1942 + 64 * (j - 30) + d;
  if (d < 4) return 768 + d;
  if (d < 22) return 1924 + (d - 4);
  if (d < 26) return 2774 + (d - 22);
  return -1;
}

DEVI void phase_prep(const Params& p, char* smem) {
  const int tid = get_tid();
  u16* WIN = (u16*)(p.ws + OFF_WIN);
  u16* WO = (u16*)(p.ws + OFF_WO);
  u16* WC1 = (u16*)(p.ws + OFF_WC1);
  float2* ROPE = (float2*)(p.ws + OFF_ROPE);
  u16* XB = (u16*)(p.ws + OFF_XB);
  unsigned* CNT = (unsigned*)(p.ws + OFF_CNT);
  constexpr int N_WIN = NL * 88 * 16, N_WO = NL * 16 * 16, N_WC1 = NL * 2 * 4 * 32, N_CB = NL * 2 * 8, N_ROPE = 256,
                N_XB = NTOK * DM / 4096, N_WR = NL * 128, N_Z = 1;
  constexpr int TOT = N_WIN + N_WO + N_WC1 + N_CB + N_ROPE + N_XB + N_WR + N_Z;
  u16* WR2 = (u16*)(p.ws + OFF_WR2);
  float* CBP = (float*)(p.ws + OFF_CBP);
  for (int it = blockIdx.x; it < TOT; it += gridDim.x) {
    int i = it;
    if (i < N_WIN) {
      const int l = i / (88 * 16), r = i % (88 * 16), grp = r / 16, kt = r % 16;
      const float* src = p.in[1] + (size_t)l * DM * NIN;
      cvt_tile([&](int np) -> const float* { int c = win_srccol(np); return c >= 0 ? src + c : nullptr; }, NIN, kt * 64,
               WIN + (size_t)l * NPAD * DM, DM, grp * 32, smem);
      continue;
    }
    i -= N_WIN;
    if (i < N_WO) {
      const int l = i / 256, r = i % 256, grp = r / 16, kt = r % 16;
      const float* src = p.in[9] + (size_t)l * DM * DM + grp * 64;
      cvt64(src, src + 32, DM, kt * 64, WO + (size_t)l * DM * DM, DM, grp * 64, [](int r) { return perm16(r); }, smem);
      continue;
    }
    i -= N_WO;
    if (i < N_WC1) {
      const int lk = i / 128, r = i % 128, grp = r / 32, kt = r % 32;
      const int l = lk >> 1, kv = lk & 1;
      const float* src = p.in[kv ? 7 : 4] + (size_t)l * 2048 * 128;
      cvt_tile([&](int np) -> const float* { return src + np; }, 128, kt * 64, WC1 + (size_t)lk * 128 * 2048, 2048, grp * 32, smem);
      continue;
    }
    i -= N_WC1;
    if (i < N_CB) {
      const int lk = i >> 3, ch = i & 7, l = lk >> 1, kv = lk & 1;
      const float* pe = p.in[kv ? 6 : 3] + (size_t)l * 2048 + ch * 256;
      const float* w1 = p.in[kv ? 7 : 4] + (size_t)l * 2048 * 128 + (size_t)ch * 256 * 128;
      const int j = tid & 127, half = tid >> 7;
      float a = 0.f;
#pragma unroll 16
      for (int k = half * 128; k < half * 128 + 128; ++k) a += pe[k] * w1[(size_t)k * 128 + j];
      float* red = (float*)smem;
      if (half) red[j] = a;
      __syncthreads();
      if (!half) CBP[(size_t)i * 128 + j] = a + red[j];
      __syncthreads();
      continue;
    }
    i -= N_CB;
    if (i < N_ROPE) {
      const int idx = i * 256 + tid;
      const int t = idx >> 5, f = idx & 31;
      const double inv = pow(10000.0, -(double)f / 32.0);
      const double ang = (double)t * inv;
      ROPE[idx] = make_float2((float)cos(ang), (float)sin(ang));
      continue;
    }
    i -= N_ROPE;
    if (i < N_XB) {
      const float* x = p.in[0] + (size_t)i * 4096;
      u16* d = XB + (size_t)i * 4096;
#pragma unroll
      for (int j = 0; j < 4; ++j) {
        const int e = (j * 256 + tid) * 4;
        const float4 v = *(const float4*)(x + e);
        *(uint2*)(d + e) = pk4(v.x, v.y, v.z, v.w);
      }
      continue;
    }
    i -= N_XB;
    if (i < N_WR) {
      const int l = i >> 7, r = i & 127, wcs = r >> 6, within = r & 63, e = wcs * 32 + (within & 31);
      const float* wsrc = p.in[12] + (size_t)l * DM * NE + e;
      u16* d = WR2 + ((size_t)l * 128 + r) * 2048;
#pragma unroll
      for (int q = 0; q < 4; ++q) {
        const int k = tid + 256 * q;
        const float wv = wsrc[(size_t)k * NE];
        const u16 hi = f2bf(wv);
        const u16 lo = f2bf(wv - bf2f(hi));
        d[k] = within < 32 ? hi : lo;
        d[1024 + k] = within < 32 ? hi : (u16)0;
      }
      continue;
    }
    i -= N_WR;
    { for (int j = tid; j < NL * 128; j += 256) CNT[j] = 0u; }
  }
}

#define XCD_LOOP(it, n)                                                            \
  for (int it = ((blockIdx.x & 7) * (((n) + 7) >> 3)) + (blockIdx.x >> 3),         \
           it##_end = min((int)(n), ((blockIdx.x & 7) + 1) * (((n) + 7) >> 3));   \
       it < it##_end; it += (gridDim.x >> 3))

DEVI void inproj_epilogue(const Params& p, f32x4 (&acc)[4][4], int m0, int n0) {
  const int tid = get_tid(), lane = tid & 63, wid = tid >> 6, wr = wid >> 1, wc = wid & 1;
  const int j = (n0 >> 6) + wc;
  const float2* ROPE = (const float2*)(p.ws + OFF_ROPE);
  u16* CH = (u16*)(p.ws + OFF_CH);
  float* MISC = (float*)(p.ws + OFF_MISC);
  const bool rope = (j >= 12 && j <= 19) || j == 22 || j == 23 || j == 26 || j == 27 || (j >= 30 && j <= 36) ||
                    (j >= 38 && j <= 42);
  const bool qs = (j < 4) || (j >= 12 && j <= 17) || (j >= 30 && j <= 35);
  const bool tr = (j >= 8 && j <= 11) || j == 24 || j == 25 || j == 28 || j == 29 || j == 37;
  const float scl = qs ? QSCALE : 1.f;
  const int dq = 4 * (lane >> 4);
#pragma unroll
  for (int m = 0; m < 4; ++m) {
    const int tok = m0 + wr * 64 + m * 16 + (lane & 15);
    const int b = tok >> 11, t = tok & 2047;
    if (j == CH_MISC) {
#pragma unroll
      for (int n = 0; n < 2; ++n) *(f32x4*)(MISC + (size_t)tok * 32 + n * 16 + dq) = acc[m][n];
      continue;
    }
    float y[4][4];
#pragma unroll
    for (int n = 0; n < 2; ++n) {
#pragma unroll
      for (int q = 0; q < 4; ++q) {
        const int d = n * 16 + dq + q;
        float x1 = acc[m][n][q], x2 = acc[m][n + 2][q];
        if (rope) {
          const float2 cs = ROPE[t * 32 + d];
          const float y1 = x1 * cs.x - x2 * cs.y, y2 = x2 * cs.x + x1 * cs.y;
          x1 = y1; x2 = y2;
        }
        y[n][q] = x1 * scl;
        y[n + 2][q] = x2 * scl;
      }
    }
    if (!tr) {
      u16* o = CH + (size_t)j * CHSZ + (size_t)tok * 64;
#pragma unroll
      for (int n = 0; n < 4; ++n) *(uint2*)(o + n * 16 + dq) = pk4(y[n][0], y[n][1], y[n][2], y[n][3]);
    } else {
      u16* o = CH + (size_t)j * CHSZ + (size_t)b * 64 * T_ + t;
#pragma unroll
      for (int n = 0; n < 4; ++n)
#pragma unroll
        for (int q = 0; q < 4; ++q) o[(size_t)(n * 16 + dq + q) * T_] = f2bf(y[n][q]);
    }
  }
}

DEVI void phase_inproj(const Params& p, int l, char* smem) {
  const int tid = get_tid();
  const u16* XB = (const u16*)(p.ws + OFF_XB);
  const u16* WIN = (const u16*)(p.ws + OFF_WIN) + (size_t)l * NPAD * DM;
  u8* WGU = (u8*)(p.ws + OFF_WGU);
  u8* WD = (u8*)(p.ws + OFF_WD);
  constexpr int N_G = 128 * 22, N_GU = 65 * 8 * 16, N_D = 65 * 16 * 4, N_C = N_GU + N_D;
  XCD_LOOP(it, N_G) {
    {
      const int mt = it / 22, nt = it % 22;
      long aoff[4];
#pragma unroll
      for (int q = 0; q < 4; ++q) aoff[q] = (long)(mt * 128 + (tid >> 3) + 32 * q) * DM;
      f32x4 acc[4][4];
      gemm128(XB, aoff, WIN, DM, nt * 128, DM, smem, acc);
      inproj_epilogue(p, acc, mt * 128, nt * 128);
    }
    __syncthreads();
    const int c0 = (int)((long)it * N_C / N_G), c1 = (int)((long)(it + 1) * N_C / N_G);
    auto make_job = [&](int i) -> CvtJob {
      if (i < N_GU) {
        const int e = i / 128, r = i % 128, grp = r / 16, kt = r % 16;
        const float* sg = (e < 64) ? p.in[14] + ((size_t)l * 64 + e) * DM * EH : p.in[17] + (size_t)l * DM * EH;
        const float* su = (e < 64) ? p.in[15] + ((size_t)l * 64 + e) * DM * EH : p.in[18] + (size_t)l * DM * EH;
        return cvt64_job(sg + grp * 32, su + grp * 32, EH, kt * 64, WGU + (size_t)e * 512 * DM, DM, grp * 64, 0, tid);
      } else {
        const int i2 = i - N_GU;
        const int e = i2 / 64, r = i2 % 64, grp = r / 4, kt = r % 4;
        const float* src = ((e < 64) ? p.in[16] + ((size_t)l * 64 + e) * EH * DM : p.in[19] + (size_t)l * EH * DM) + grp * 64;
        return cvt64_job(src, src + 32, DM, kt * 64, WD + (size_t)e * DM * EH, EH, grp * 64, 1, tid);
      }
    };
    if (c0 < c1) {
      CvtJob job = make_job(c0);
      float4 cur[4], nxt[4];
      cvt64_load(job, cur);
      for (int i = c0; i < c1; ++i) {
        CvtJob njob = job;
        if (i + 1 < c1) { njob = make_job(i + 1); cvt64_load(njob, nxt); }
        cvt64_store(job, cur, smem);
        job = njob;
#pragma unroll
        for (int q = 0; q < 4; ++q) cur[q] = nxt[q];
      }
      __syncthreads();
    }
  }
}

DEVI void gemm32_direct(const u16* __restrict__ arow, const u16* __restrict__ brow, int K, f32x16& acc, int h) {
  arow += 8 * h;
  brow += 8 * h;
#pragma unroll 2
  for (int k0 = 0; k0 < K; k0 += 64) {
    bf8 a[4], b[4];
#pragma unroll
    for (int s = 0; s < 4; ++s) { a[s] = *(const bf8*)(arow + k0 + 16 * s); b[s] = *(const bf8*)(brow + k0 + 16 * s); }
#pragma unroll
    for (int s = 0; s < 4; ++s) acc = __builtin_amdgcn_mfma_f32_32x32x16_bf16(a[s], b[s], acc, 0, 0, 0);
  }
}

DEVI void gemm32x128_ksplit(const u16* __restrict__ arow, const u16* __restrict__ bt, long ldb, int K, float* out, int wid, int lane) {
  const int h = lane >> 5;
  const int kq = K >> 2;
  f32x16 acc[4];
#pragma unroll
  for (int c = 0; c < 4; ++c)
#pragma unroll
    for (int r = 0; r < 16; ++r) acc[c][r] = 0.f;
  const u16* ap = arow + wid * kq + 8 * h;
  const u16* bp = bt + (long)(lane & 31) * ldb + wid * kq + 8 * h;
#pragma unroll 1
  for (int k0 = 0; k0 < kq; k0 += 64) {
    bf8 a[4];
#pragma unroll
    for (int s = 0; s < 4; ++s) a[s] = *(const bf8*)(ap + k0 + 16 * s);
#pragma unroll
    for (int c2 = 0; c2 < 4; c2 += 2) {
      bf8 b[2][4];
#pragma unroll
      for (int c = 0; c < 2; ++c)
#pragma unroll
        for (int s = 0; s < 4; ++s) b[c][s] = *(const bf8*)(bp + (long)(c2 + c) * 32 * ldb + k0 + 16 * s);
#pragma unroll
      for (int c = 0; c < 2; ++c)
#pragma unroll
        for (int s = 0; s < 4; ++s) acc[c2 + c] = __builtin_amdgcn_mfma_f32_32x32x16_bf16(a[s], b[c][s], acc[c2 + c], 0, 0, 0);
      __builtin_amdgcn_sched_barrier(0);
    }
  }
#pragma unroll 1
  for (int w = 0; w < 4; ++w) {
    if (wid == w) {
#pragma unroll
      for (int c = 0; c < 4; ++c)
#pragma unroll
        for (int r = 0; r < 16; ++r) {
          float* o = out + ((r & 3) + 8 * (r >> 2) + 4 * h) * 129 + c * 32 + (lane & 31);
          *o = (w == 0) ? acc[c][r] : *o + acc[c][r];
        }
    }
    __syncthreads();
  }
}

DEVI float gelu_tanh(float x) {
  const float u = 0.7978845608028654f * (x + 0.044715f * x * x * x);
  return 0.5f * x * (1.f + tanhf(u));
}

DEVI void item_s2(const Params& p, int l, int bsel, int it2, char* smem) {
  const int tid = get_tid(), lane = tid & 63, wid = tid >> 6, h = lane >> 5;
  const float* MISC = (const float*)(p.ws + OFF_MISC);
  float* CL = (float*)(p.ws + OFF_CL);
  const u16* CH = (const u16*)(p.ws + OFF_CH);
  const u16* WC1 = (const u16*)(p.ws + OFF_WC1);
  const float* CBP = (const float*)(p.ws + OFF_CBP);
  u16* KCMP = (u16*)(p.ws + OFF_KCMP);
  u16* VCMPT = (u16*)(p.ws + OFF_VCMPT);
  {
    if (it2 < 4) {
      const int b = bsel, hh = it2;
      const float fb = p.in[2][l * 4 + hh];
      double* part = (double*)smem;
      double loc[8];
      double run = 0.0;
#pragma unroll
      for (int j = 0; j < 8; ++j) {
        const int t = tid * 8 + j;
        const float f = MISC[(size_t)(b * T_ + t) * 32 + hh] + fb;
        const float ls = fminf(f, 0.f) - log1pf(__expf(-fabsf(f)));
        run += (double)ls;
        loc[j] = run;
      }
      part[tid] = run;
      __syncthreads();
      if (tid == 0) {
        double sacc = 0.0;
        for (int j = 0; j < 256; ++j) { const double v = part[j]; part[j] = sacc; sacc += v; }
      }
      __syncthreads();
      const double base = part[tid];
#pragma unroll
      for (int j = 0; j < 8; ++j) CL[(size_t)(b * 4 + hh) * T_ + tid * 8 + j] = (float)(-(base + loc[j]) * (double)LOG2E);
      __syncthreads();
      return;
    }
    const int it = it2 - 4;
    const int ch = it & 3, kv = (it >> 2) & 1, g = (it >> 3) & 1, b = bsel;
    const u16* A = CH + (size_t)((kv ? CH_NSAVC : CH_NSAKC) + g) * CHSZ + (size_t)b * T_ * 64;
    int c = ch * 32 + (lane & 31);
    c = c > 126 ? 126 : c;
    const float* cbp = CBP + (size_t)(l * 2 + kv) * 8 * 128;
    float* HID = (float*)smem;
    gemm32x128_ksplit(A + (size_t)c * 1024, WC1 + (size_t)(l * 2 + kv) * 128 * 2048, 2048, 2048, HID, wid, lane);
    {
      const int col = tid & 127;
      float bsum = 0.f;
#pragma unroll
      for (int q = 0; q < 8; ++q) bsum += cbp[q * 128 + col];
#pragma unroll
      for (int i = 0; i < 16; ++i) {
        float* hp = HID + ((tid >> 7) + 2 * i) * 129 + col;
        *hp = gelu_tanh(*hp + bsum);
      }
    }
    __syncthreads();
    {
      const float* w2 = p.in[kv ? 8 : 5] + (size_t)l * 128 * 64;
      const int d = tid & 63, rq = tid >> 6;
      float o[8];
#pragma unroll
      for (int r = 0; r < 8; ++r) o[r] = 0.f;
#pragma unroll 4
      for (int k = 0; k < 128; ++k) {
        const float wv = w2[k * 64 + d];
#pragma unroll
        for (int r = 0; r < 8; ++r) o[r] += HID[(rq + 4 * r) * 129 + k] * wv;
      }
#pragma unroll
      for (int r = 0; r < 8; ++r) {
        const int cc = ch * 32 + rq + 4 * r;
        const float v = (cc < 127) ? o[r] : 0.f;
        if (!kv) KCMP[((size_t)(b * 2 + g) * 128 + cc) * 64 + d] = f2bf(v);
        else VCMPT[((size_t)(b * 2 + g) * 64 + d) * 128 + cc] = f2bf(v);
      }
    }
    __syncthreads();
  }
}

DEVI void load_qfrag(const u16* Qrow  , int lane, bf8 (&qf)[4]) {
  const int h = lane >> 5;
#pragma unroll
  for (int s = 0; s < 4; ++s) qf[s] = *(const bf8*)(Qrow + 16 * s + 8 * h);
}

DEVI void load_tile64(const u16* src, long ld, char* lds) {
  const int tid = get_tid();
#pragma unroll
  for (int i = 0; i < 2; ++i) {
    const int pslot = tid + 256 * i, row = pslot >> 3, cp = pslot & 7;
    const int c = cp ^ ((row >> 1) & 7);
    glds16(src + (long)row * ld + c * 8, lds + tid * 16 + i * 4096);
  }
}

enum { M_FOX = 0, M_WIN = 1, M_SLC = 2, M_DSA = 3 };

template <int MODE>
DEVI void flash_block(const bf8 (&qf)[4], const u16* K, const u16* Vt, int q0, int kt0, int kt1, const float* bias,
                      unsigned selm, unsigned umask, const u64* dmrow, char* smem, f32x16 (&O)[2]) {
  const int tid = get_tid(), lane = tid & 63, wid = tid >> 6, h = lane >> 5;
  const int qw0 = q0 + 32 * wid, q = qw0 + (lane & 31);
  O[0] = (f32x16){0.f}; O[1] = (f32x16){0.f};
#pragma unroll
  for (int r = 0; r < 16; ++r) { O[0][r] = 0.f; O[1][r] = 0.f; }
  float mrun = -1e30f, lrun = 0.f;
  const int swk = ((lane & 31) >> 1) & 7;
  u64 um64 = ~0ull;
  if (MODE == M_SLC) um64 = (u64)umask;
  um64 &= (kt1 >= 64 ? ~0ull : ((1ull << kt1) - 1ull)) & (~0ull << kt0);
  auto issue = [&](int kt, int buf) {
    char* base = smem + buf * 16896;
    const int k0 = kt * 64;
    load_tile64(K + (long)k0 * 64, 64, base);
    load_tile64(Vt + k0, T_, base + 8192);
    if (MODE == M_FOX) { if (tid < 16) glds16(bias + k0 + tid * 4, base + 16384 + tid * 16); }
  };
  __syncthreads();
  int kt = um64 ? (int)__builtin_ctzll(um64) : 64;
  u64 dm_pref = 0;
  if (MODE == M_DSA) { if (kt < 64) dm_pref = dmrow[kt]; }
  if (kt < 64) issue(kt, 0);
  int cur = 0;
  while (kt < 64) {
    const u64 rem = (kt >= 63) ? 0ull : (um64 & (~0ull << (kt + 1)));
    const int nxt = rem ? (int)__builtin_ctzll(rem) : 64;
    wait_vm0();
    __syncthreads();
    u64 dm_next = 0;
    if (MODE == M_DSA) { dm_next = dm_pref; if (nxt < 64) dm_pref = dmrow[nxt]; }
    if (nxt < 64) issue(nxt, cur ^ 1);
    const char* SK = smem + cur * 16896;
    const char* SV = SK + 8192;
    const float* SBias = (const float*)(SK + 16384);
    const int k0 = kt * 64;
    bool active = true;
    if (MODE != M_DSA) active = (k0 <= qw0 + 31);
    if (MODE == M_WIN) active = active && (k0 + 63 >= qw0 - 511);
    u64 dm = 0;
    if (MODE == M_DSA) { dm = dm_next; }
    if (active) {
      f32x16 S[2];
#pragma unroll
      for (int tk = 0; tk < 2; ++tk) {
        if (MODE == M_FOX) {
#pragma unroll
          for (int g4 = 0; g4 < 4; ++g4) {
            const f32x4 bv = *(const f32x4*)(SBias + 32 * tk + 8 * g4 + 4 * h);
#pragma unroll
            for (int e = 0; e < 4; ++e) S[tk][4 * g4 + e] = bv[e];
          }
        } else if (MODE == M_SLC) {
          const float iv = ((selm >> kt) & 1u) ? 0.f : -INFINITY;
#pragma unroll
          for (int r = 0; r < 16; ++r) S[tk][r] = iv;
        } else if (MODE == M_DSA) {
          const unsigned w4 = (tk ? (unsigned)(dm >> 32) : (unsigned)dm) >> (4 * h);
#pragma unroll
          for (int g4 = 0; g4 < 4; ++g4)
#pragma unroll
            for (int e = 0; e < 4; ++e)
              S[tk][4 * g4 + e] = __uint_as_float(~(unsigned)__builtin_amdgcn_sbfe((int)w4, 8 * g4 + e, 1) & 0xff800000u);
        } else {
#pragma unroll
          for (int r = 0; r < 16; ++r) S[tk][r] = 0.f;
        }
        __builtin_amdgcn_s_setprio(1);
#pragma unroll
        for (int s = 0; s < 4; ++s) {
          const bf8 kf = *(const bf8*)(SK + (32 * tk + (lane & 31)) * 128 + (((2 * s + h) ^ swk) << 4));
          S[tk] = __builtin_amdgcn_mfma_f32_32x32x16_bf16(kf, qf[s], S[tk], 0, 0, 0);
        }
        __builtin_amdgcn_s_setprio(0);
      }
      const bool diag = (MODE != M_DSA) && (k0 + 63 > qw0);
      const bool lowb = (MODE == M_WIN) && (k0 < qw0 + 31 - 511);
      if (diag || lowb) {
#pragma unroll
        for (int tk = 0; tk < 2; ++tk)
#pragma unroll
          for (int r = 0; r < 16; ++r) {
            const int key = k0 + 32 * tk + 8 * (r >> 2) + 4 * h + (r & 3);
            bool valid = key <= q;
            if (MODE == M_WIN) valid = valid && (key > q - 512);
            S[tk][r] = valid ? S[tk][r] : -INFINITY;
          }
      }
      float mx = fmaxf(S[0][0], S[1][0]);
#pragma unroll
      for (int r = 1; r < 16; ++r) mx = fmaxf(mx, fmaxf(S[0][r], S[1][r]));
      mx = fmaxf(mx, __shfl_xor(mx, 32));
      const float mnew = fmaxf(mrun, mx);
      const float alpha = fexp2(mrun - mnew);
      const bool grew = mnew > mrun;
      mrun = mnew;
      float ps = 0.f;
      bf8 pf[2][2];
#pragma unroll
      for (int tk = 0; tk < 2; ++tk)
#pragma unroll
        for (int r = 0; r < 16; ++r) {
          const float pv = fexp2(S[tk][r] - mnew);
          ps += pv;
          pf[tk][r >> 3][r & 7] = (__bf16)pv;
        }
      lrun = lrun * alpha + ps;
      if (__any(grew)) {
#pragma unroll
        for (int r = 0; r < 16; ++r) { O[0][r] *= alpha; O[1][r] *= alpha; }
      }
      __builtin_amdgcn_sched_barrier(0);
      __builtin_amdgcn_s_setprio(1);
#pragma unroll
      for (int dt = 0; dt < 2; ++dt) {
        const int d = 32 * dt + (lane & 31);
        const char* vrow = SV + d * 128;
        const int swv = (d >> 1) & 7;
#pragma unroll
        for (int tk = 0; tk < 2; ++tk)
#pragma unroll
          for (int s = 0; s < 2; ++s) {
            const int c1 = 4 * tk + 2 * s;
            const bf4 lo = *(const bf4*)(vrow + ((c1 ^ swv) << 4) + 8 * h);
            const bf4 hi = *(const bf4*)(vrow + (((c1 + 1) ^ swv) << 4) + 8 * h);
            bf8 vf;
            vf[0] = lo[0]; vf[1] = lo[1]; vf[2] = lo[2]; vf[3] = lo[3];
            vf[4] = hi[0]; vf[5] = hi[1]; vf[6] = hi[2]; vf[7] = hi[3];
            O[dt] = __builtin_amdgcn_mfma_f32_32x32x16_bf16(vf, pf[tk][s], O[dt], 0, 0, 0);
          }
      }
      __builtin_amdgcn_s_setprio(0);
    }
    kt = nxt;
    cur ^= 1;
  }
  const float lt = lrun + __shfl_xor(lrun, 32);
  const float inv = lt > 0.f ? 1.f / lt : 0.f;
#pragma unroll
  for (int r = 0; r < 16; ++r) { O[0][r] *= inv; O[1][r] *= inv; }
}

DEVI void store_o(const f32x16 (&O)[2], u16* orow  , int lane) {
  const int h = lane >> 5;
#pragma unroll
  for (int dt = 0; dt < 2; ++dt)
#pragma unroll
    for (int g4 = 0; g4 < 4; ++g4)
      *(uint2*)(orow + 32 * dt + 8 * g4 + 4 * h) = pk4(O[dt][4 * g4], O[dt][4 * g4 + 1], O[dt][4 * g4 + 2], O[dt][4 * g4 + 3]);
}

DEVI void item_fox(const Params& p, int b, int h, int qb, char* smem) {
  const int tid = get_tid(), lane = tid & 63, wid = tid >> 6;
  const u16* CH = (const u16*)(p.ws + OFF_CH);
  const u16* Q = CH + (size_t)(CH_FOXQ + h) * CHSZ + (size_t)b * T_ * 64;
  const u16* K = CH + (size_t)(CH_FOXK + h) * CHSZ + (size_t)b * T_ * 64;
  const u16* Vt = CH + (size_t)(CH_FOXV + h) * CHSZ + (size_t)b * 64 * T_;
  const float* bias = (const float*)(p.ws + OFF_CL) + (size_t)(b * 4 + h) * T_;
  const int q0 = qb * 128, q = q0 + 32 * wid + (lane & 31);
  bf8 qf[4];
  load_qfrag(Q + (size_t)q * 64, lane, qf);
  f32x16 O[2];
  flash_block<M_FOX>(qf, K, Vt, q0, 0, q0 / 64 + 2, bias, 0u, 0u, nullptr, smem, O);
  u16* o = (u16*)(p.ws + OFF_O) + (size_t)(b * T_ + q) * DM + h * 64;
  store_o(O, o, lane);
}

DEVI void item_cmp(const Params& p, int b, int g, int qb, char* smem) {
  const int tid = get_tid(), lane = tid & 63, wid = tid >> 6, h = lane >> 5;
  const int bg = b * 2 + g;
  const u16* CH = (const u16*)(p.ws + OFF_CH);
  const u16* KC = (const u16*)(p.ws + OFF_KCMP) + (size_t)bg * 128 * 64;
  const u16* VCT = (const u16*)(p.ws + OFF_VCMPT) + (size_t)bg * 64 * 128;
  const float* MISC = (const float*)(p.ws + OFF_MISC);
  float* OCMP = (float*)(p.ws + OFF_OCMP);
  unsigned* SELM = (unsigned*)(p.ws + OFF_SELM);
  char* SK = smem;
  char* SV = smem + 16384;
  load_tile64(KC, 64, SK);
  load_tile64(KC + 64 * 64, 64, SK + 8192);
#pragma unroll
  for (int j = 0; j < 4; ++j) {
    const int pslot = tid + 256 * j, row = pslot >> 4, cp = pslot & 15;
    const int c = cp ^ ((row >> 1) & 7);
    glds16(VCT + (size_t)row * 128 + c * 8, SV + tid * 16 + j * 4096);
  }
  wait_vm0();
  __syncthreads();
  const int q0 = qb * 128, qw0 = q0 + 32 * wid, t = qw0 + (lane & 31);
  const int tok = b * T_ + t;
  const int swk = ((lane & 31) >> 1) & 7;
  float* GLg = (float*)(smem + 32768) + wid * 2112 + (lane & 31) * 33;
  float* GLl = GLg + 1056;
#pragma unroll
  for (int j = 0; j < 16; ++j) { GLg[2 * j + h] = 0.f; GLl[2 * j + h] = 0.f; }
  int nvis = t >= 31 ? ((t - 31) >> 4) + 1 : 0;
  nvis = nvis > 127 ? 127 : nvis;
#pragma unroll 1
  for (int r3 = 0; r3 < 3; ++r3) {
    const int head = g * 3 + r3;
    bf8 qf[4];
    load_qfrag(CH + (size_t)(CH_NSAQ + head) * CHSZ + (size_t)tok * 64, lane, qf);
    int nv = nvis;
    asm volatile("" : "+v"(nv));
    float mrun = -1e30f, lrun = 0.f;
#pragma unroll 1
    for (int tk = 0; tk < 4; ++tk) {
      f32x16 S;
#pragma unroll
      for (int r = 0; r < 16; ++r) S[r] = 0.f;
#pragma unroll
      for (int s = 0; s < 4; ++s) {
        const bf8 kf = *(const bf8*)(SK + (32 * tk + (lane & 31)) * 128 + (((2 * s + h) ^ swk) << 4));
        S = __builtin_amdgcn_mfma_f32_32x32x16_bf16(kf, qf[s], S, 0, 0, 0);
      }
      float mx = -INFINITY;
#pragma unroll
      for (int r = 0; r < 16; ++r) {
        const int c = 32 * tk + 8 * (r >> 2) + 4 * h + (r & 3);
        const bool valid = c < nv;
        const float sv = valid ? S[r] : -INFINITY;
        S[r] = sv;
        mx = fmaxf(mx, sv);
      }
      mx = fmaxf(mx, __shfl_xor(mx, 32));
      const float mnew = fmaxf(mrun, mx);
      float ps = 0.f;
#pragma unroll
      for (int r = 0; r < 16; ++r) ps += fexp2(S[r] - mnew);
      lrun = lrun * fexp2(mrun - mnew) + ps;
      mrun = mnew;
    }
    const float lt = lrun + __shfl_xor(lrun, 32);
    const float inv = lt > 0.f ? 1.f / lt : 0.f;
    asm volatile("" : "+v"(nv));
    f32x16 O[2];
#pragma unroll
    for (int r = 0; r < 16; ++r) { O[0][r] = 0.f; O[1][r] = 0.f; }
#pragma unroll
    for (int tk = 0; tk < 4; ++tk) {
      f32x16 S;
#pragma unroll
      for (int r = 0; r < 16; ++r) S[r] = 0.f;
#pragma unroll
      for (int s = 0; s < 4; ++s) {
        const bf8 kf = *(const bf8*)(SK + (32 * tk + (lane & 31)) * 128 + (((2 * s + h) ^ swk) << 4));
        S = __builtin_amdgcn_mfma_f32_32x32x16_bf16(kf, qf[s], S, 0, 0, 0);
      }
      bf8 pf[2];
#pragma unroll
      for (int r = 0; r < 16; ++r) {
        const int c = 32 * tk + 8 * (r >> 2) + 4 * h + (r & 3);
        const bool valid = c < nv;
        const float pv = valid ? fexp2(S[r] - mrun) * inv : 0.f;
        S[r] = pv;
        pf[r >> 3][r & 7] = (__bf16)pv;
      }
#pragma unroll
      for (int g4 = 0; g4 < 4; ++g4) {
        const int j = 2 * (4 * tk + g4) + h;
        GLg[j] += (S[4 * g4] + S[4 * g4 + 1]) + (S[4 * g4 + 2] + S[4 * g4 + 3]);
        GLl[j] += S[4 * g4 + 3];
      }
#pragma unroll
      for (int dt = 0; dt < 2; ++dt) {
        const int d = 32 * dt + (lane & 31);
        const char* vrow = SV + d * 256;
        const int swv = (d >> 1) & 7;
#pragma unroll
        for (int s = 0; s < 2; ++s) {
          const int c1 = 4 * tk + 2 * s;
          const bf4 lo = *(const bf4*)(vrow + ((c1 ^ swv) << 4) + 8 * h);
          const bf4 hi = *(const bf4*)(vrow + (((c1 + 1) ^ swv) << 4) + 8 * h);
          bf8 vf;
          vf[0] = lo[0]; vf[1] = lo[1]; vf[2] = lo[2]; vf[3] = lo[3];
          vf[4] = hi[0]; vf[5] = hi[1]; vf[6] = hi[2]; vf[7] = hi[3];
          O[dt] = __builtin_amdgcn_mfma_f32_32x32x16_bf16(vf, pf[s], O[dt], 0, 0, 0);
        }
      }
      __builtin_amdgcn_sched_barrier(0);
    }
    const float gate = sigmoidf_(MISC[(size_t)tok * 32 + 4 + head]);
    float* oc = OCMP + (size_t)tok * 384 + head * 64;
#pragma unroll
    for (int dt = 0; dt < 2; ++dt)
#pragma unroll
      for (int g4 = 0; g4 < 4; ++g4) {
        f32x4 v = (f32x4){O[dt][4 * g4] * gate, O[dt][4 * g4 + 1] * gate, O[dt][4 * g4 + 2] * gate, O[dt][4 * g4 + 3] * gate};
        *(f32x4*)(oc + 32 * dt + 8 * g4 + 4 * h) = v;
      }
  }
  {
    const int blk_t = t >> 6;
    float w[32];
#pragma unroll
    for (int k = 0; k < 32; ++k) {
      const int j = (k + h) & 31;
      float x = GLg[j] + (j > 0 ? GLl[j > 0 ? j - 1 : 0] : 0.f);
      const bool forced = (j == 0) || (j == blk_t) || (j == blk_t - 1);
      x = (j <= blk_t) ? (forced ? 1e6f : x) : -1.f;
      w[k] = x;
    }
    unsigned mask = 0;
#pragma unroll
    for (int jj = 0; jj < 16; ++jj) {
      const int k0 = 2 * jj;
      const float vj = w[k0];
      int rank = 0;
#pragma unroll
      for (int k = 0; k < 32; ++k) {
        const bool lower = (k < k0) || (k == 31 && h);
        rank += (w[k] > vj) || (w[k] == vj && lower);
      }
      if (rank < 16) mask |= 1u << (k0 + h);
    }
    mask |= __shfl_xor(mask, 32);
    if (h == 0) SELM[(size_t)bg * T_ + t] = mask;
  }
  __syncthreads();
}

template <int NJ>
DEVI void idx_select(const float* scr, u64* DMASK, int b, int q0, int wid, int lane) {
  auto load_keys = [&](int rr, float (&raw)[NJ]) {
    if (q0 + rr >= 256) {
      const float* src = scr + (size_t)rr * 2048 + lane;
#pragma unroll
      for (int j = 0; j < NJ; ++j) raw[j] = __builtin_nontemporal_load(src + 64 * j);
    }
  };
  auto select_row = [&](int rr, const float (&raw)[NJ]) {
    const int tr = q0 + rr;
    u64* drow = DMASK + (size_t)(b * T_ + tr) * 32;
    if (tr < 256) {
      if (lane < 32) {
        const int lo = lane * 64;
        drow[lane] = (tr >= lo + 63) ? ~0ull : (tr < lo ? 0ull : ((2ull << (tr - lo)) - 1ull));
      }
      return;
    }
    unsigned key[NJ];
#pragma unroll
    for (int j = 0; j < NJ; ++j) {
      const unsigned bits = __float_as_uint(raw[j]);
      const unsigned kk = (bits & 0x80000000u) ? ~bits : (bits | 0x80000000u);
      key[j] = (lane + 64 * j <= tr) ? kk : 0u;
    }
    unsigned prefix = 0u;
    for (int bit = 31; bit >= 0; --bit) {
      const unsigned cand = prefix | (1u << bit);
      int cl = 0;
#pragma unroll
      for (int j = 0; j < NJ; ++j) cl += (key[j] >= cand) ? 1 : 0;
      int c = 0;
#pragma unroll
      for (int sb = 0; sb < 6; ++sb) c += __popcll(__ballot((cl >> sb) & 1)) << sb;
      if (c >= 256) prefix = cand;
      if (c == 256) break;
    }
    int cgl = 0;
#pragma unroll
    for (int j = 0; j < NJ; ++j) cgl += (key[j] > prefix) ? 1 : 0;
    int cgt = 0;
#pragma unroll
    for (int sb = 0; sb < 6; ++sb) cgt += __popcll(__ballot((cgl >> sb) & 1)) << sb;
    int need = 256 - cgt;
    const u64 lt_mask = (1ull << lane) - 1ull;
#pragma unroll
    for (int j = 0; j < NJ; ++j) {
      const u64 eqm = __ballot(key[j] == prefix);
      const int myrank = __popcll(eqm & lt_mask);
      const bool sel = (key[j] > prefix) || (key[j] == prefix && myrank < need);
      need -= __popcll(eqm);
      const u64 word = __ballot(sel);
      if (lane == 0) drow[j] = word;
    }
    if (NJ < 32) { if (lane >= NJ && lane < 32) drow[lane] = 0ull; }
  };
  float ka[NJ], kb[NJ];
  load_keys(wid * 8, ka);
#pragma unroll 1
  for (int r2 = 0; r2 < 4; ++r2) {
    const int rr = wid * 8 + 2 * r2;
    load_keys(rr + 1, kb);
    select_row(rr, ka);
    if (r2 < 3) load_keys(rr + 2, ka);
    select_row(rr + 1, kb);
  }
}

DEVI void item_idx(const Params& p, int b, int qb, char* smem, int pflags) {
  const int tid = get_tid(), lane = tid & 63, wid = tid >> 6, h = lane >> 5;
  const u16* CH = (const u16*)(p.ws + OFF_CH);
  const u16* KI = CH + (size_t)CH_IDXK * CHSZ + (size_t)b * T_ * 64;
  const float* MISC = (const float*)(p.ws + OFF_MISC);
  float* scr = (float*)(p.ws + OFF_DSCR) + (size_t)blockIdx.x * 32 * 2048;
  u64* DMASK = (u64*)(p.ws + ((pflags & 16) ? WS_NEED : OFF_DMASK));
  const int q0 = qb * 32, t = q0 + (lane & 31), tok = b * T_ + t;
  const int nkt = q0 / 64 + 1;
  if (!(pflags & 16)) {
    bf8 qf[4][4];
    float w[4];
#pragma unroll
    for (int hd = 0; hd < 4; ++hd) {
      load_qfrag(CH + (size_t)(CH_IDXQ + hd) * CHSZ + (size_t)tok * 64, lane, qf[hd]);
      w[hd] = MISC[(size_t)tok * 32 + 22 + hd];
    }
    for (int kt = wid; kt < nkt; kt += 4) {
      const int k0 = kt * 64;
#pragma unroll
      for (int tk = 0; tk < 2; ++tk) {
        bf8 kf[4];
        const u16* krow = KI + (size_t)(k0 + 32 * tk + (lane & 31)) * 64;
#pragma unroll
        for (int s = 0; s < 4; ++s) kf[s] = *(const bf8*)(krow + 16 * s + 8 * h);
        f32x16 sc;
#pragma unroll
        for (int r = 0; r < 16; ++r) sc[r] = 0.f;
#pragma unroll
        for (int hd = 0; hd < 4; ++hd) {
          f32x16 S;
#pragma unroll
          for (int r = 0; r < 16; ++r) S[r] = 0.f;
#pragma unroll
          for (int s = 0; s < 4; ++s) S = __builtin_amdgcn_mfma_f32_32x32x16_bf16(kf[s], qf[hd][s], S, 0, 0, 0);
#pragma unroll
          for (int r = 0; r < 16; ++r) sc[r] += w[hd] * fmaxf(S[r], 0.f);
        }
        float* dst = scr + (size_t)(lane & 31) * 2048 + k0 + 32 * tk + 4 * h;
#pragma unroll
        for (int g4 = 0; g4 < 4; ++g4)
          *(f32x4*)(dst + 8 * g4) = (f32x4){sc[4 * g4] + 0.f, sc[4 * g4 + 1] + 0.f, sc[4 * g4 + 2] + 0.f, sc[4 * g4 + 3] + 0.f};
      }
    }
  }
  wait_vm0();
  __syncthreads();
  if (!(pflags & 8)) {
    const int njr = (nkt + 7) >> 3;
    if (njr <= 1) idx_select<8>(scr, DMASK, b, q0, wid, lane);
    else if (njr == 2) idx_select<16>(scr, DMASK, b, q0, wid, lane);
    else if (njr == 3) idx_select<24>(scr, DMASK, b, q0, wid, lane);
    else idx_select<32>(scr, DMASK, b, q0, wid, lane);
  }
  __syncthreads();
}

DEVI void phase_s3a(const Params& p, int l, char* smem, int psub) {
  const int b = blockIdx.x & 7;
  unsigned* bar = (unsigned*)(p.ws + OFF_BAR);
  unsigned* ctr = bar + XB_WCTR + (l * 2) * 8 + b;
  unsigned* s2done = bar + XB_WCTR + 320 + (l & 15) * 8 + b;
  const unsigned s2need = (l >= 16) ? 40u : 20u;
  bool s2ready = false;
  for (int it = next_item(ctr, smem); it < 180; it = next_item(ctr, smem)) {
    if (it < 20) {
      item_s2(p, l & 15, b, it, smem);
      wait_vm0();
      __syncthreads();
      if (threadIdx.x == 0) {
        __builtin_amdgcn_fence(__ATOMIC_RELEASE, "agent");
        asm volatile("s_waitcnt vmcnt(0)" ::: "memory");
        (void)xb_add(s2done, 1u);
      }
      continue;
    }
    const int i2 = it - 20;
    if (l >= 16) {
      if (i2 < 64) { if (!(psub & 1)) continue; }
      else if (i2 < 128) { if (!(psub & 2)) continue; }
      else { if (!(psub & 4)) continue; }
    }
    if (i2 >= 64 && !s2ready) {
      if (threadIdx.x == 0) {
        XB_SPIN(xb_ld(s2done) < s2need, bar);
        __builtin_amdgcn_fence(__ATOMIC_ACQUIRE, "agent");
        asm volatile("s_waitcnt vmcnt(0)" ::: "memory");
      }
      __syncthreads();
      s2ready = true;
    }
    if (i2 < 64) item_idx(p, b, 63 - i2, smem, l >= 16 ? psub : 0);
    else if (i2 < 128) item_fox(p, b, (i2 - 64) & 3, 15 - ((i2 - 64) >> 2), smem);
    else item_cmp(p, b, (i2 - 128) >> 4, (i2 - 128) & 15, smem);
  }
}

DEVI void item_nsa(const Params& p, int b, int head, int qb, char* smem) {
  const int tid = get_tid(), lane = tid & 63, wid = tid >> 6, h = lane >> 5;
  const int g = head / 3;
  const u16* CH = (const u16*)(p.ws + OFF_CH);
  const float* MISC = (const float*)(p.ws + OFF_MISC);
  const int q0 = qb * 128, q = q0 + 32 * wid + (lane & 31), tok = b * T_ + q;
  bf8 qf[4];
  load_qfrag(CH + (size_t)(CH_NSAQ + head) * CHSZ + (size_t)tok * 64, lane, qf);
  const unsigned selm = ((const unsigned*)(p.ws + OFF_SELM))[(size_t)(b * 2 + g) * T_ + q];
  unsigned um = selm;
#pragma unroll
  for (int o = 32; o > 0; o >>= 1) um |= __shfl_xor(um, o);
  unsigned* red = (unsigned*)(smem + 40960);
  if (lane == 0) red[wid] = um;
  __syncthreads();
  um = red[0] | red[1] | red[2] | red[3];
  __syncthreads();
  f32x16 O1[2], O2[2];
  flash_block<M_SLC>(qf, CH + (size_t)(CH_NSAKS + g) * CHSZ + (size_t)b * T_ * 64,
                     CH + (size_t)(CH_NSAVS + g) * CHSZ + (size_t)b * 64 * T_, q0, 0, q0 / 64 + 2, nullptr, selm, um, nullptr, smem, O1);
  int kt0 = (q0 - 511) >> 6;
  kt0 = kt0 < 0 ? 0 : kt0;
  flash_block<M_WIN>(qf, CH + (size_t)(CH_NSAKW + g) * CHSZ + (size_t)b * T_ * 64,
                     CH + (size_t)(CH_NSAVW + g) * CHSZ + (size_t)b * 64 * T_, q0, kt0, q0 / 64 + 2, nullptr, 0u, 0u, nullptr, smem, O2);
  const float g1 = sigmoidf_(MISC[(size_t)tok * 32 + 4 + 6 + head]);
  const float g2 = sigmoidf_(MISC[(size_t)tok * 32 + 4 + 12 + head]);
  const float* oc = (const float*)(p.ws + OFF_OCMP) + (size_t)tok * 384 + head * 64;
  u16* o = (u16*)(p.ws + OFF_O) + (size_t)tok * DM + 256 + head * 64;
#pragma unroll
  for (int dt = 0; dt < 2; ++dt)
#pragma unroll
    for (int g4 = 0; g4 < 4; ++g4) {
      const int d = 32 * dt + 8 * g4 + 4 * h;
      const f32x4 c = *(const f32x4*)(oc + d);
      float v[4];
#pragma unroll
      for (int e = 0; e < 4; ++e) v[e] = c[e] + g1 * O1[dt][4 * g4 + e] + g2 * O2[dt][4 * g4 + e];
      *(uint2*)(o + d) = pk4(v[0], v[1], v[2], v[3]);
    }
}

DEVI void item_dsa(const Params& p, int b, int head, int qb, char* smem) {
  const int tid = get_tid(), lane = tid & 63, wid = tid >> 6;
  const u16* CH = (const u16*)(p.ws + OFF_CH);
  const int q0 = qb * 128, q = q0 + 32 * wid + (lane & 31), tok = b * T_ + q;
  bf8 qf[4];
  load_qfrag(CH + (size_t)(CH_DSAQ + head) * CHSZ + (size_t)tok * 64, lane, qf);
  const u64* dmrow = (const u64*)(p.ws + OFF_DMASK) + (size_t)tok * 32;
  f32x16 O[2];
  flash_block<M_DSA>(qf, CH + (size_t)CH_DSAK * CHSZ + (size_t)b * T_ * 64, CH + (size_t)CH_DSAV * CHSZ + (size_t)b * 64 * T_, q0, 0,
                     q0 / 64 + 2, nullptr, 0u, 0u, dmrow, smem, O);
  u16* o = (u16*)(p.ws + OFF_O) + (size_t)tok * DM + 640 + head * 64;
  store_o(O, o, lane);
}

DEVI void phase_s3b(const Params& p, int l, char* smem, int psub) {
  const int b = blockIdx.x & 7;
  unsigned* ctr = (unsigned*)(p.ws + OFF_BAR) + XB_WCTR + (l * 2 + 1) * 8 + b;
  for (int it = next_item(ctr, smem); it < 192; it = next_item(ctr, smem)) {
    const int j = it >> 1;
    if (l >= 16) { if (!((psub >> (it & 1)) & 1)) continue; }
    if (it & 1) item_dsa(p, b, j % 6, 15 - j / 6, smem);
    else item_nsa(p, b, j % 6, 15 - j / 6, smem);
  }
}

DEVI void phase_outproj(const Params& p, int l, char* smem) {
  const int tid = get_tid(), lane = tid & 63, wid = tid >> 6, wr = wid >> 1, wc = wid & 1;
  const u16* O = (const u16*)(p.ws + OFF_O);
  const u16* WO = (const u16*)(p.ws + OFF_WO) + (size_t)l * DM * DM;
  const float* xin = l == 0 ? p.in[0] : (const float*)(p.ws + OFF_XBUF);
  float* h1 = (float*)(p.ws + OFF_XBUF);
  XCD_LOOP(it, 128 * 8) {
    const int mt = it >> 3, nt = it & 7;
    long aoff[4];
#pragma unroll
    for (int q = 0; q < 4; ++q) aoff[q] = (long)(mt * 128 + (tid >> 3) + 32 * q) * DM;
    f32x4 acc[4][4];
    gemm128(O, aoff, WO, DM, nt * 128, DM, smem, acc);
#pragma unroll
    for (int m = 0; m < 4; ++m) {
      const size_t row = mt * 128 + wr * 64 + m * 16 + (lane & 15);
      const int col0 = nt * 128 + wc * 64 + 16 * (lane >> 4);
#pragma unroll
      for (int n = 0; n < 4; ++n) {
        const f32x4 xv = *(const f32x4*)(xin + row * DM + col0 + 4 * n);
        f32x4 v;
#pragma unroll
        for (int q = 0; q < 4; ++q) v[q] = ALPHA * xv[q] + acc[m][n][q];
        *(f32x4*)(h1 + row * DM + col0 + 4 * n) = v;
      }
    }
  }
}

DEVI void ln_row(float (&v)[16], const float* g, const float* bta, int lane) {
  float s = 0.f;
#pragma unroll
  for (int j = 0; j < 16; ++j) s += v[j];
  const float mu = wave_sum(s) * (1.f / DM);
  float s2 = 0.f;
#pragma unroll
  for (int j = 0; j < 16; ++j) { const float d = v[j] - mu; s2 += d * d; }
  const float rstd = rsqrtf(wave_sum(s2) * (1.f / DM) + LN_EPS);
#pragma unroll
  for (int i = 0; i < 4; ++i) {
    const int c = lane * 4 + 256 * i;
    const float4 gg = *(const float4*)(g + c), bb = *(const float4*)(bta + c);
    v[4 * i + 0] = (v[4 * i + 0] - mu) * rstd * gg.x + bb.x;
    v[4 * i + 1] = (v[4 * i + 1] - mu) * rstd * gg.y + bb.y;
    v[4 * i + 2] = (v[4 * i + 2] - mu) * rstd * gg.z + bb.z;
    v[4 * i + 3] = (v[4 * i + 3] - mu) * rstd * gg.w + bb.w;
  }
}

DEVI void ln_row8(float (&v)[16], const float* g, const float* bta, int lane) {
  float s = 0.f;
#pragma unroll
  for (int j = 0; j < 16; ++j) s += v[j];
  const float mu = wave_sum(s) * (1.f / DM);
  float s2 = 0.f;
#pragma unroll
  for (int j = 0; j < 16; ++j) { const float d = v[j] - mu; s2 += d * d; }
  const float rstd = rsqrtf(wave_sum(s2) * (1.f / DM) + LN_EPS);
#pragma unroll
  for (int i = 0; i < 2; ++i) {
    const int c = lane * 8 + 512 * i;
#pragma unroll
    for (int h = 0; h < 2; ++h) {
      const float4 gg = *(const float4*)(g + c + 4 * h), bb = *(const float4*)(bta + c + 4 * h);
      v[8 * i + 4 * h + 0] = (v[8 * i + 4 * h + 0] - mu) * rstd * gg.x + bb.x;
      v[8 * i + 4 * h + 1] = (v[8 * i + 4 * h + 1] - mu) * rstd * gg.y + bb.y;
      v[8 * i + 4 * h + 2] = (v[8 * i + 4 * h + 2] - mu) * rstd * gg.z + bb.z;
      v[8 * i + 4 * h + 3] = (v[8 * i + 4 * h + 3] - mu) * rstd * gg.w + bb.w;
    }
  }
}

DEVI void phase_ln1_router(const Params& p, int l, char* smem, int dup) {
  const int tid = get_tid(), lane = tid & 63, wid = tid >> 6, h = lane >> 5;
  const float* h1 = (const float*)(p.ws + OFF_XBUF);
  u8* X8 = (u8*)(p.ws + OFF_XA);
  u16* XB = (u16*)(p.ws + OFF_XB);
  u16* XL = (u16*)(p.ws + OFF_XL);
  const float* g1 = p.in[10] + l * DM;
  const float* b1 = p.in[11] + l * DM;
  const u16* WR2 = (const u16*)(p.ws + OFF_WR2) + (size_t)l * 128 * 2048;
  const float* BR = p.in[13] + l * NE;
  unsigned* CNT = (unsigned*)(p.ws + OFF_CNT) + l * 128 + 64 * dup;
  unsigned* LIST = (unsigned*)(p.ws + OFF_LIST);
  float* LISTW = (float*)(p.ws + OFF_LISTW);
  float* LG = (float*)smem;
  unsigned* lcnt = (unsigned*)(smem + 16640);
  unsigned* lbase = lcnt + 64;
  unsigned* pinfo = lcnt + 128;
  float* pgw = (float*)(pinfo + 256);
  for (int it = blockIdx.x; it < NTOK / 32; it += gridDim.x) {
    {
      const size_t tok0 = (size_t)it * 32 + wid * 8;
      float4 nx[4];
#pragma unroll
      for (int i = 0; i < 2; ++i) {
        nx[2 * i] = *(const float4*)(h1 + tok0 * DM + lane * 8 + 512 * i);
        nx[2 * i + 1] = *(const float4*)(h1 + tok0 * DM + lane * 8 + 512 * i + 4);
      }
#pragma unroll 1
      for (int tt = 0; tt < 8; ++tt) {
        const size_t tok = tok0 + tt;
        float v[16];
#pragma unroll
        for (int i = 0; i < 4; ++i) { v[4 * i] = nx[i].x; v[4 * i + 1] = nx[i].y; v[4 * i + 2] = nx[i].z; v[4 * i + 3] = nx[i].w; }
        if (tt < 7) {
#pragma unroll
          for (int i = 0; i < 2; ++i) {
            nx[2 * i] = *(const float4*)(h1 + (tok + 1) * DM + lane * 8 + 512 * i);
            nx[2 * i + 1] = *(const float4*)(h1 + (tok + 1) * DM + lane * 8 + 512 * i + 4);
          }
        }
        ln_row8(v, g1, b1, lane);
#pragma unroll
        for (int i = 0; i < 2; ++i) {
          const int c = lane * 8 + 512 * i;
          uint4 hi, lo;
          hi.x = pk2(v[8 * i], v[8 * i + 1]); hi.y = pk2(v[8 * i + 2], v[8 * i + 3]);
          hi.z = pk2(v[8 * i + 4], v[8 * i + 5]); hi.w = pk2(v[8 * i + 6], v[8 * i + 7]);
          *(uint4*)(XB + tok * DM + c) = hi;
          *(uint2*)(X8 + tok * DM + c) = make_uint2(pk4_f8c(v[8 * i], v[8 * i + 1], v[8 * i + 2], v[8 * i + 3]),
                                                    pk4_f8c(v[8 * i + 4], v[8 * i + 5], v[8 * i + 6], v[8 * i + 7]));
          lo.x = pk2(v[8 * i] - __uint_as_float(hi.x << 16), v[8 * i + 1] - __uint_as_float(hi.x & 0xffff0000u));
          lo.y = pk2(v[8 * i + 2] - __uint_as_float(hi.y << 16), v[8 * i + 3] - __uint_as_float(hi.y & 0xffff0000u));
          lo.z = pk2(v[8 * i + 4] - __uint_as_float(hi.z << 16), v[8 * i + 5] - __uint_as_float(hi.z & 0xffff0000u));
          lo.w = pk2(v[8 * i + 6] - __uint_as_float(hi.w << 16), v[8 * i + 7] - __uint_as_float(hi.w & 0xffff0000u));
          *(uint4*)(XL + tok * DM + c) = lo;
        }
      }
    }
    if (tid < 64) lcnt[tid] = 0u;
    wait_vm0();
    __syncthreads();
    {
      const size_t trow = ((size_t)it * 32 + (lane & 31)) * DM;
      const u16* arow = (wid < 2 ? XB + trow : XL + trow - 1024);
      gemm32x128_ksplit(arow, WR2, 2048, 2048, LG, wid, lane);
    }
    const float br = BR[lane];
    const int lgc = (lane >> 5) * 64 + (lane & 31);
    for (int tt = 0; tt < 8; ++tt) {
      const int tl = wid * 8 + tt;
      const float s = sigmoidf_(LG[tl * 129 + lgc] + LG[tl * 129 + lgc + 32]);
      const float sb = s + br;
      int cnt = 0;
#pragma unroll
      for (int d = 1; d < 8; ++d) {
        const int src = (lane & ~7) | ((lane + d) & 7);
        const float o = __shfl(sb, src);
        cnt += (o > sb) || (o == sb && src < lane);
      }
      float gs = cnt < 2 ? sb : 0.f;
      gs += __shfl_xor(gs, 1); gs += __shfl_xor(gs, 2); gs += __shfl_xor(gs, 4);
      int grank = 0;
      const int myg = lane >> 3;
#pragma unroll
      for (int g = 0; g < 8; ++g) {
        const float og = __shfl(gs, g * 8);
        grank += (og > gs) || (og == gs && g < myg);
      }
      const float vsel = grank < 4 ? sb : -1e30f;
      int rank = 0;
#pragma unroll 8
      for (int j = 0; j < 64; ++j) {
        const float oj = __shfl(vsel, j);
        rank += (oj > vsel) || (oj == vsel && j < lane);
      }
      const bool sel = rank < 8;
      const float ssum = wave_sum(sel ? s : 0.f);
      if (sel) {
        const unsigned ls = atomicAdd(&lcnt[lane], 1u);
        pinfo[tl * 8 + rank] = (unsigned)lane | (ls << 8);
        pgw[tl * 8 + rank] = s / ssum * 2.5f;
      }
    }
    __syncthreads();
    if (tid < 64) lbase[tid] = atomicAdd(&CNT[tid], lcnt[tid]);
    __syncthreads();
    {
      const unsigned inf = pinfo[tid];
      const unsigned e = inf & 255u, ls = inf >> 8;
      const unsigned pid = (unsigned)(it * 32) * 8u + (unsigned)tid;
      LIST[(size_t)e * NTOK + lbase[e] + ls] = pid;
      LISTW[(size_t)e * NTOK + lbase[e] + ls] = pgw[tid];
    }
    __syncthreads();
  }
}

DEVI void build_tiles(const unsigned* CNT, int* tb, int* rowb, int* cnts) {
  const int tid = get_tid();
  if (tid < 64) {
    const int c = (int)CNT[tid];
    const int nb = (c + 127) >> 7;
    int st = nb, sr = c;
#pragma unroll
    for (int o = 1; o < 64; o <<= 1) {
      const int t2 = __shfl_up(st, o), r2 = __shfl_up(sr, o);
      if (tid >= o) { st += t2; sr += r2; }
    }
    tb[tid] = st - nb; rowb[tid] = sr - c; cnts[tid] = c;
    if (tid == 63) { tb[64] = st; rowb[64] = sr; cnts[64] = NTOK; tb[65] = st + (NTOK >> 7); }
  }
  __syncthreads();
}

DEVI void phase_gateup(const Params& p, int l, char* smem) {
  const int tid = get_tid(), lane = tid & 63, wid = tid >> 6, wr = wid >> 1, wc = wid & 1;
  const unsigned* CNT = (const unsigned*)(p.ws + OFF_CNT) + l * 128;
  const unsigned* LIST = (const unsigned*)(p.ws + OFF_LIST);
  const u8* X8 = (const u8*)(p.ws + OFF_XA);
  const u8* WGU = (const u8*)(p.ws + OFF_WGU);
  u8* H = (u8*)(p.ws + OFF_H);
  int* tb = (int*)(smem + 65536);
  int* rowb = tb + 72;
  int* cnts = rowb + 72;
  build_tiles(CNT, tb, rowb, cnts);
  const int ntiles = tb[65];
  int e_nxt = 0, e_cur = 0;
  auto load_rows = [&](int it, int (&tokr)[4]) {
    const int rbt = it >> 2;
    int e = e_nxt;
    while (tb[e + 1] <= rbt) ++e;
    e_nxt = e;
    const int rb = rbt - tb[e], cnt = cnts[e];
#pragma unroll
    for (int q = 0; q < 4; ++q) {
      int r = rb * 128 + (tid >> 3) + 32 * q;
      r = r < cnt ? r : cnt - 1;
      tokr[q] = e < 64 ? (int)(LIST[(size_t)e * NTOK + r] >> 3) : r;
    }
  };
  const int n_it = ntiles * 4, it_step = gridDim.x >> 3;
  const int it_beg = ((blockIdx.x & 7) * ((n_it + 7) >> 3)) + (blockIdx.x >> 3);
  const int it_end = min(n_it, ((blockIdx.x & 7) + 1) * ((n_it + 7) >> 3));
  int tokn[4] = {0, 0, 0, 0};
  if (it_beg < it_end) load_rows(it_beg, tokn);
  for (int it = it_beg; it < it_end; it += it_step) {
    const int rbt = it >> 2, nt = it & 3;
    int e = e_cur;
    while (tb[e + 1] <= rbt) ++e;
    e_cur = e;
    const int rb = rbt - tb[e], cnt = cnts[e];
    long aoff[4];
#pragma unroll
    for (int q = 0; q < 4; ++q) aoff[q] = (long)tokn[q] * DM;
    if (it + it_step < it_end) load_rows(it + it_step, tokn);
    f32x4 acc[4][4];
    gemm128_f8(X8, aoff, WGU + (size_t)e * 512 * DM, DM, nt * 128, DM, smem, acc);
    const int g64 = nt * 2 + wc;
#pragma unroll
    for (int m = 0; m < 4; ++m) {
      const int r = rb * 128 + wr * 64 + m * 16 + (lane & 15);
      if (r < cnt) {
        u8* hrow = H + (size_t)(rowb[e] + r) * EH + g64 * 32;
#pragma unroll
        for (int n = 0; n < 2; ++n) {
          float v[4];
#pragma unroll
          for (int q = 0; q < 4; ++q) {
            const float gt = acc[m][n][q] * (1.f / F8_SW), up = acc[m][n + 2][q] * (1.f / F8_SW);
            v[q] = gt / (1.f + __expf(-gt)) * up * F8_SH;
          }
          *(unsigned*)(hrow + n * 16 + 4 * (lane >> 4)) = pk4_f8c(v[0], v[1], v[2], v[3]);
        }
      }
    }
  }
}

DEVI void phase_down(const Params& p, int l, char* smem, int pflags = 0) {
  const int tid = get_tid(), lane = tid & 63, wid = tid >> 6, wr = wid >> 1, wc = wid & 1;
  const unsigned* CNT = (const unsigned*)(p.ws + OFF_CNT) + l * 128;
  const unsigned* LIST = (const unsigned*)(p.ws + OFF_LIST);
  const float* LISTW = (const float*)(p.ws + OFF_LISTW);
  const u8* WD = (const u8*)(p.ws + OFF_WD);
  const u8* H = (const u8*)(p.ws + OFF_H);
  u8* Y = (u8*)(p.ws + OFF_Y);
  u8* YSH = (u8*)(p.ws + OFF_YSH);
  int* tb = (int*)(smem + 65536);
  int* rowb = tb + 72;
  int* cnts = rowb + 72;
  build_tiles(CNT, tb, rowb, cnts);
  const int ntiles = tb[65];
  int e_nxt = 0, e_cur = 0;
  auto load_meta = [&](int it, unsigned (&pid)[4], float (&w)[4]) {
    const int rbt = it >> 1;
    int e = e_nxt;
    while (tb[e + 1] <= rbt) ++e;
    e_nxt = e;
    const int rb = rbt - tb[e], cnt = cnts[e];
#pragma unroll
    for (int m = 0; m < 4; ++m) {
      int r = rb * 128 + wr * 64 + m * 16 + (lane & 15);
      r = r < cnt ? r : cnt - 1;
      if (e < 64) { pid[m] = LIST[(size_t)e * NTOK + r]; w[m] = LISTW[(size_t)e * NTOK + r]; }
      else { pid[m] = (unsigned)r; w[m] = 1.f; }
    }
  };
  const int n_it = ntiles * 2, it_step = gridDim.x >> 3;
  const int it_beg = ((blockIdx.x & 7) * ((n_it + 7) >> 3)) + (blockIdx.x >> 3);
  const int it_end = min(n_it, ((blockIdx.x & 7) + 1) * ((n_it + 7) >> 3));
  unsigned pidn[4] = {0u, 0u, 0u, 0u};
  float wn[4] = {1.f, 1.f, 1.f, 1.f};
  if (it_beg < it_end) load_meta(it_beg, pidn, wn);
  for (int it = it_beg; it < it_end; it += it_step) {
    const int rbt = it >> 1, nh = it & 1;
    int e = e_cur;
    while (tb[e + 1] <= rbt) ++e;
    e_cur = e;
    const int rb = rbt - tb[e], cnt = cnts[e];
    long aoff[4];
#pragma unroll
    for (int q = 0; q < 4; ++q) aoff[q] = (long)(rowb[e] + rb * 128 + (tid >> 3) + 32 * q) * EH;
    u8* yrow[4];
    float wrow[4];
#pragma unroll
    for (int m = 0; m < 4; ++m) {
      const int r = rb * 128 + wr * 64 + m * 16 + (lane & 15);
      wrow[m] = wn[m];
      u8* dst = e < 64 ? Y + (size_t)pidn[m] * DM : YSH + (size_t)pidn[m] * DM;
      yrow[m] = (r < cnt && !(pflags & 32)) ? dst : (u8*)(p.ws + WS_NEED) + (size_t)(tid & 255) * DM;
    }
    if (it + it_step < it_end) load_meta(it + it_step, pidn, wn);
    gemm128_stream_f8<4>(H, aoff, WD + (size_t)e * DM * EH, EH, nh * 512, 4, EH, smem, [&](int tile, f32x4 (&acc)[4][4]) {
#pragma unroll
      for (int m = 0; m < 4; ++m) {
        const float w = wrow[m] * (F8_SY / (F8_SW * F8_SH));
        const int col0 = nh * 512 + tile * 128 + wc * 64 + 16 * (lane >> 4);
        uint4 v0;
        v0.x = pk4_f8c(acc[m][0][0] * w, acc[m][0][1] * w, acc[m][0][2] * w, acc[m][0][3] * w);
        v0.y = pk4_f8c(acc[m][1][0] * w, acc[m][1][1] * w, acc[m][1][2] * w, acc[m][1][3] * w);
        v0.z = pk4_f8c(acc[m][2][0] * w, acc[m][2][1] * w, acc[m][2][2] * w, acc[m][2][3] * w);
        v0.w = pk4_f8c(acc[m][3][0] * w, acc[m][3][1] * w, acc[m][3][2] * w, acc[m][3][3] * w);
        if (pflags & 64) {
          asm volatile("" ::"v"(v0.x), "v"(v0.y), "v"(v0.z), "v"(v0.w));
        } else {
          *(uint4*)(yrow[m] + col0) = v0;
        }
      }
      return !(pflags & 64);
    });
  }
}

DEVI void phase_combine(const Params& p, int l, char* smem) {
  const int tid = get_tid(), lane = tid & 63, wid = tid >> 6;
  const u16* XBr = (const u16*)(p.ws + OFF_XB);
  const u16* XLr = (const u16*)(p.ws + OFF_XL);
  const u8* Y = (const u8*)(p.ws + OFF_Y);
  const u8* YSH = (const u8*)(p.ws + OFF_YSH);
  float* XO = l == NL - 1 ? p.out : (float*)(p.ws + OFF_XBUF);
  u16* XB = (u16*)(p.ws + OFF_XB);
  const float* g2 = p.in[20] + l * DM;
  const float* b2 = p.in[21] + l * DM;
  for (int it = blockIdx.x; it < NTOK / 4; it += gridDim.x) {
    const size_t tok = (size_t)it * 4 + wid;
    float v[16];
    uint2 yv[2][9];
    float4 xv[2][2];
#pragma unroll
    for (int i = 0; i < 2; ++i) {
      const int c = lane * 8 + 512 * i;
      {
        const uint4 xh = *(const uint4*)(XBr + tok * DM + c), xl = *(const uint4*)(XLr + tok * DM + c);
        xv[i][0] = make_float4(__uint_as_float(xh.x << 16) + __uint_as_float(xl.x << 16), __uint_as_float(xh.x & 0xffff0000u) + __uint_as_float(xl.x & 0xffff0000u),
                               __uint_as_float(xh.y << 16) + __uint_as_float(xl.y << 16), __uint_as_float(xh.y & 0xffff0000u) + __uint_as_float(xl.y & 0xffff0000u));
        xv[i][1] = make_float4(__uint_as_float(xh.z << 16) + __uint_as_float(xl.z << 16), __uint_as_float(xh.z & 0xffff0000u) + __uint_as_float(xl.z & 0xffff0000u),
                               __uint_as_float(xh.w << 16) + __uint_as_float(xl.w << 16), __uint_as_float(xh.w & 0xffff0000u) + __uint_as_float(xl.w & 0xffff0000u));
      }
#pragma unroll
      for (int k = 0; k < 8; ++k) yv[i][k] = *(const uint2*)(Y + (tok * 8 + k) * DM + c);
      yv[i][8] = *(const uint2*)(YSH + tok * DM + c);
    }
#pragma unroll
    for (int i = 0; i < 2; ++i) {
      typedef __attribute__((ext_vector_type(2))) float f32x2_;
      float a[8] = {0.f, 0.f, 0.f, 0.f, 0.f, 0.f, 0.f, 0.f};
#pragma unroll
      for (int k = 0; k < 9; ++k) {
        const uint2 y = yv[i][k];
        const f32x2_ d0 = __builtin_amdgcn_cvt_pk_f32_fp8((int)y.x, false), d1 = __builtin_amdgcn_cvt_pk_f32_fp8((int)y.x, true);
        const f32x2_ d2 = __builtin_amdgcn_cvt_pk_f32_fp8((int)y.y, false), d3 = __builtin_amdgcn_cvt_pk_f32_fp8((int)y.y, true);
        a[0] += d0[0]; a[1] += d0[1]; a[2] += d1[0]; a[3] += d1[1];
        a[4] += d2[0]; a[5] += d2[1]; a[6] += d3[0]; a[7] += d3[1];
      }
      const float xs[8] = {xv[i][0].x, xv[i][0].y, xv[i][0].z, xv[i][0].w, xv[i][1].x, xv[i][1].y, xv[i][1].z, xv[i][1].w};
#pragma unroll
      for (int j = 0; j < 8; ++j) v[8 * i + j] = ALPHA * xs[j] + a[j] * (1.f / F8_SY);
    }
    ln_row8(v, g2, b2, lane);
#pragma unroll
    for (int i = 0; i < 2; ++i) {
      const int c = lane * 8 + 512 * i;
      *(float4*)(XO + tok * DM + c) = make_float4(v[8 * i], v[8 * i + 1], v[8 * i + 2], v[8 * i + 3]);
      *(float4*)(XO + tok * DM + c + 4) = make_float4(v[8 * i + 4], v[8 * i + 5], v[8 * i + 6], v[8 * i + 7]);
      if (l < NL - 1) {
        uint4 o;
        o.x = pk2(v[8 * i], v[8 * i + 1]); o.y = pk2(v[8 * i + 2], v[8 * i + 3]);
        o.z = pk2(v[8 * i + 4], v[8 * i + 5]); o.w = pk2(v[8 * i + 6], v[8 * i + 7]);
        *(uint4*)(XB + tok * DM + c) = o;
      }
    }
  }
}

constexpr int NPL = 10;
constexpr int NPHASE = 1 + NPL * NL;
constexpr int SMEM_BYTES = 66816;

#if MEGA
#define RUN_PHASE(S, CALL)                                              \
  {                                                                     \
    const int nrep_ = (pdup == (S)) ? 2 : 1;                            \
    for (int dup = 0; dup < nrep_; ++dup) {                             \
      Params p = pin;                                                   \
      asm volatile("" : "+s"(p.ws));   \
      CALL;                                                             \
      xcd_barrier(xb);                                                  \
    }                                                                   \
  }

__global__ void __launch_bounds__(256, 2) fwd_kernel(Params pin, int pdup, int psub) {
  __shared__ __attribute__((aligned(16))) char smem[SMEM_BYTES];
  volatile LAS unsigned* st = (volatile LAS unsigned*)(smem + 66576);
  if (threadIdx.x == 0) { st[0] = 0u; st[1] = 0u; }
  __syncthreads();
  XcdBarrier xb = xcd_barrier_post((unsigned*)(pin.ws + OFF_BAR), st);
  {
    const int nrep_ = (pdup == 10) ? 2 : 1;
    for (int dup = 0; dup < nrep_; ++dup) {
      Params p = pin;
      asm volatile("" : "+s"(p.ws));
      phase_prep(p, smem);
      if (pdup == 0x7fffffff) cg::this_grid().sync();
      xcd_barrier(xb);
    }
  }
#pragma unroll 1
  for (int l = 0; l < NL; ++l) {
    RUN_PHASE(0, phase_inproj(p, l, smem))
    RUN_PHASE(2, phase_s3a(p, l + 16 * dup, smem, psub))
    RUN_PHASE(3, phase_s3b(p, l + 16 * dup, smem, psub))
    RUN_PHASE(4, phase_outproj(p, l, smem))
    RUN_PHASE(5, phase_ln1_router(p, l, smem, dup))
    RUN_PHASE(7, phase_gateup(p, l, smem))
    RUN_PHASE(8, phase_down(p, l, smem, dup ? psub : 0))
    RUN_PHASE(9, phase_combine(p, l, smem))
  }
}
#endif

extern "C" void kernel_launch(void* const* d_in, const int* in_sizes, int n_in, void* d_out, int out_size, void* d_ws,
                              size_t ws_size, hipStream_t stream) {
  if (ws_size < WS_NEED) fprintf(stderr, "workspace too small: %zu < %zu\n", ws_size, (size_t)WS_NEED);
  Params p{};
  for (int i = 0; i < 22; ++i) p.in[i] = (const float*)d_in[i];
  p.out = (float*)d_out;
  p.ws = (char*)d_ws;
#if MEGA
  static int grid_blocks = 0;
  if (!grid_blocks) {
    int dev = 0, cus = 0, per_cu = 0;
    (void)hipGetDevice(&dev);
    (void)hipDeviceGetAttribute(&cus, hipDeviceAttributeMultiprocessorCount, dev);
    (void)hipOccupancyMaxActiveBlocksPerMultiprocessor(&per_cu, fwd_kernel, 256, 0);
    if (per_cu > 2) per_cu = 2;
    if (per_cu < 1) per_cu = 1;
    grid_blocks = cus * per_cu;
    if (grid_blocks > MAXGRID) grid_blocks = MAXGRID;
  }
  (void)hipMemsetAsync((char*)d_ws + OFF_BAR, 0, BAR_BYTES, stream);
  int pdup = PROBE_DUP, psub = PROBE_SUB;
  void* args[] = {&p, &pdup, &psub};
  hipError_t e = hipLaunchCooperativeKernel((void*)fwd_kernel, dim3(grid_blocks), dim3(256), args, 0, stream);
  if (e != hipSuccess) fprintf(stderr, "cooperative launch failed: %s (grid %d)\n", hipGetErrorString(e), grid_blocks);
#endif
}
```

```cpp
#include <hip/hip_runtime.h>
#include <hip/hip_cooperative_groups.h>
#include <cstdio>
#include <cstdint>
namespace cg = cooperative_groups;

#ifndef MEGA
#define MEGA 1
#endif
#define PROBE_DUP -1
#define PROBE_SUB 0

typedef __attribute__((ext_vector_type(8))) __bf16 bf8;
typedef __attribute__((ext_vector_type(4))) __bf16 bf4;
typedef __attribute__((ext_vector_type(4))) float f32x4;
typedef __attribute__((ext_vector_type(16))) float f32x16;
typedef unsigned short u16;
typedef unsigned long long u64;

#define DEVI __device__ __forceinline__

constexpr int B_ = 8, T_ = 2048, DM = 1024, NTOK = B_ * T_, NL = 4;
constexpr int NIN = 2778, NPAD = 2816, NCH = 44;
constexpr int NE = 64, EH = 256;
constexpr float ALPHA = 1.681792830507429f;
constexpr float LOG2E = 1.4426950408889634f;
constexpr float QSCALE = 0.125f * LOG2E;
constexpr float LN_EPS = 1e-5f;

constexpr int CH_FOXQ = 0, CH_FOXK = 4, CH_FOXV = 8, CH_NSAQ = 12, CH_NSAKC = 18, CH_NSAVC = 20, CH_NSAKS = 22,
              CH_NSAVS = 24, CH_NSAKW = 26, CH_NSAVW = 28, CH_DSAQ = 30, CH_DSAK = 36, CH_DSAV = 37, CH_IDXQ = 38,
              CH_IDXK = 42, CH_MISC = 43;
constexpr size_t CHSZ = (size_t)B_ * T_ * 64;

constexpr size_t al256(size_t x) { return (x + 255) & ~(size_t)255; }
constexpr size_t OFF_WIN = 0;
constexpr size_t OFF_WO = OFF_WIN + al256((size_t)NL * NPAD * DM * 2);
constexpr size_t OFF_WC1 = OFF_WO + al256((size_t)NL * DM * DM * 2);
constexpr size_t OFF_CB = OFF_WC1 + al256((size_t)NL * 2 * 128 * 2048 * 2);
constexpr size_t OFF_ROPE = OFF_CB + al256((size_t)NL * 2 * 128 * 4);
constexpr size_t OFF_WGU = OFF_ROPE + al256((size_t)T_ * 32 * 8);
constexpr size_t OFF_WD = OFF_WGU + al256((size_t)65 * 512 * DM * 2);
constexpr size_t OFF_XB = OFF_WD + al256((size_t)65 * DM * EH * 2);
constexpr size_t OFF_XA = OFF_XB + al256((size_t)NTOK * DM * 2);
constexpr size_t OFF_XBUF = OFF_XA + al256((size_t)NTOK * DM * 4);
constexpr size_t OFF_O = OFF_XBUF + al256((size_t)NTOK * DM * 4);
constexpr size_t OFF_CNT = OFF_O + al256((size_t)NTOK * DM * 2);
constexpr size_t OFF_LIST = OFF_CNT + al256((size_t)NL * 128 * 4);
constexpr size_t OFF_PAIRW = OFF_LIST + al256((size_t)NE * NTOK * 4);
constexpr size_t OFF_LISTW = OFF_PAIRW + al256((size_t)NTOK * 8 * 4);
constexpr size_t OFF_XL = OFF_LISTW + al256((size_t)NE * NTOK * 4);
constexpr size_t OFF_WR2 = OFF_XL + al256((size_t)NTOK * DM * 2);
constexpr size_t OFF_CBP = OFF_WR2 + al256((size_t)NL * 128 * 2048 * 2);
constexpr size_t OFF_BAR = OFF_CBP + al256((size_t)NL * 2 * 8 * 128 * 4);
constexpr size_t BAR_BYTES = 16384 * 9;
constexpr size_t OFF_SCR = OFF_BAR + BAR_BYTES;
constexpr size_t OFF_CH = OFF_SCR;
constexpr size_t OFF_MISC = OFF_CH + al256((size_t)43 * CHSZ * 2);
constexpr size_t OFF_CL = OFF_MISC + al256((size_t)NTOK * 32 * 4);
constexpr size_t OFF_KCMP = OFF_CL + al256((size_t)B_ * 4 * T_ * 4);
constexpr size_t OFF_VCMPT = OFF_KCMP + al256((size_t)B_ * 2 * 128 * 64 * 2);
constexpr size_t OFF_OCMP = OFF_VCMPT + al256((size_t)B_ * 2 * 64 * 128 * 2);
constexpr size_t OFF_SELM = OFF_OCMP + al256((size_t)NTOK * 384 * 4);
constexpr size_t OFF_DMASK = OFF_SELM + al256((size_t)B_ * 2 * T_ * 4);
constexpr size_t OFF_DSCR = OFF_DMASK + al256((size_t)NTOK * 32 * 8);
constexpr int MAXGRID = 768;
constexpr size_t ATT_END = OFF_DSCR + (size_t)MAXGRID * 32 * 2048 * 4;
constexpr size_t OFF_H = OFF_SCR;
constexpr size_t OFF_Y = OFF_H + al256((size_t)(NTOK * 9 + 256) * EH * 2);
constexpr size_t OFF_YSH = OFF_Y + al256((size_t)NTOK * 8 * DM * 2);
constexpr size_t MOE_END = OFF_YSH + al256((size_t)NTOK * DM * 2);
constexpr size_t WS_NEED = ATT_END > MOE_END ? ATT_END : MOE_END;

struct Params {
  const float* in[22];
  float* out;
  char* ws;
};

DEVI int get_tid() { int t = threadIdx.x; asm volatile("" : "+v"(t)); return t; }
DEVI float bf2f(u16 v) { return __uint_as_float(((unsigned)v) << 16); }
DEVI u16 f2bf(float f) { __bf16 b = (__bf16)f; return __builtin_bit_cast(u16, b); }
DEVI unsigned pk2(float a, float b) { return (unsigned)f2bf(a) | ((unsigned)f2bf(b) << 16); }
DEVI uint2 pk4(float a, float b, float c, float d) { return make_uint2(pk2(a, b), pk2(c, d)); }
DEVI float fexp2(float x) { return __builtin_amdgcn_exp2f(x); }
DEVI float sigmoidf_(float x) { return 1.f / (1.f + __expf(-x)); }
template <int CTRL, int RMASK>
DEVI int dpp_mov0(int x) { return __builtin_amdgcn_update_dpp(0, x, CTRL, RMASK, 0xf, false); }
DEVI float wave_sum(float v) {
#define WS_STEP(C, M) v += __builtin_bit_cast(float, dpp_mov0<C, M>(__builtin_bit_cast(int, v)));
  WS_STEP(0xB1, 0xf) WS_STEP(0x4E, 0xf) WS_STEP(0x141, 0xf) WS_STEP(0x140, 0xf) WS_STEP(0x142, 0xa) WS_STEP(0x143, 0xc)
#undef WS_STEP
  return __builtin_bit_cast(float, __builtin_amdgcn_readlane(__builtin_bit_cast(int, v), 63));
}
DEVI unsigned wave_max_u(unsigned v) {
#define WM_STEP(C, M) { const unsigned t_ = (unsigned)dpp_mov0<C, M>((int)v); v = t_ > v ? t_ : v; }
  WM_STEP(0xB1, 0xf) WM_STEP(0x4E, 0xf) WM_STEP(0x141, 0xf) WM_STEP(0x140, 0xf) WM_STEP(0x142, 0xa) WM_STEP(0x143, 0xc)
#undef WM_STEP
  return (unsigned)__builtin_amdgcn_readlane((int)v, 63);
}
DEVI float xhalf_max(float v) {
  const auto r = __builtin_amdgcn_permlane32_swap(__float_as_uint(v), __float_as_uint(v), false, false);
  return fmaxf(__uint_as_float(r[0]), __uint_as_float(r[1]));
}
DEVI float xhalf_sum(float v) {
  const auto r = __builtin_amdgcn_permlane32_swap(__float_as_uint(v), __float_as_uint(v), false, false);
  return __uint_as_float(r[0]) + __uint_as_float(r[1]);
}
DEVI unsigned xhalf_or(unsigned v) {
  const auto r = __builtin_amdgcn_permlane32_swap(v, v, false, false);
  return r[0] | r[1];
}
DEVI unsigned grp8_max_u(unsigned v) {
#define G8_STEP(C) { const unsigned t_ = (unsigned)dpp_mov0<C, 0xf>((int)v); v = t_ > v ? t_ : v; }
  G8_STEP(0xB1) G8_STEP(0x4E) G8_STEP(0x141)
#undef G8_STEP
  return v;
}
DEVI float grp8_sum(float v) {
#define G8_STEP(C) v += __builtin_bit_cast(float, dpp_mov0<C, 0xf>(__builtin_bit_cast(int, v)));
  G8_STEP(0xB1) G8_STEP(0x4E) G8_STEP(0x141)
#undef G8_STEP
  return v;
}
DEVI void glds16(const void* g, void* l) {
  __builtin_amdgcn_global_load_lds((const unsigned*)g, (unsigned*)l, 16, 0, 0);
}
DEVI void wait_vm0() { asm volatile("s_waitcnt vmcnt(0)" ::: "memory"); }
DEVI float ld_sc1(const float* p) { return __hip_atomic_load(p, __ATOMIC_RELAXED, __HIP_MEMORY_SCOPE_AGENT); }

#define XB_TMO      128
#define XB_XCNT(j)  (256  + 64 * (j))
#define XB_XSUB(j)  (1280 + 64 * (j))
#define XB_XGEN(j)  (2304 + 64 * (j))
#define XB_TOP      3328
#define XB_TOPGEN   3392
#define XB_WCTR     3456
#define XB_SPIN_CAP (1u << 22)
#define LAS __attribute__((address_space(3)))
DEVI unsigned xb_ld(unsigned* p) { return __hip_atomic_load(p, __ATOMIC_RELAXED, __HIP_MEMORY_SCOPE_AGENT); }
DEVI unsigned xb_add(unsigned* p, unsigned v) { return __hip_atomic_fetch_add(p, v, __ATOMIC_RELAXED, __HIP_MEMORY_SCOPE_AGENT); }
DEVI unsigned xb_xcc_id() { return (unsigned)__builtin_amdgcn_s_getreg((3 << 11) | 20) & 0xFu; }
#define XB_SPIN(cond, bar) do { unsigned _sp = 0; while (cond) { __builtin_amdgcn_s_sleep(1); \
    if ((++_sp & 255u) == 0u) { if (xb_ld(&(bar)[XB_TMO])) break; if (_sp > XB_SPIN_CAP) { atomicAdd(&(bar)[XB_TMO], 1u); break; } } } } while (0)
struct XcdBarrier { unsigned* bar; unsigned x; volatile LAS unsigned* st; unsigned G; };
DEVI XcdBarrier xcd_barrier_post(unsigned* bar, volatile LAS unsigned* st, unsigned G) {
  XcdBarrier b; b.bar = bar; b.x = xb_xcc_id(); b.st = st; b.G = G;
  if (threadIdx.x == 0) (void)xb_add(&bar[XB_XCNT(b.x)], 1u);
  return b;
}
DEVI void xcd_barrier_complete(unsigned* bar, unsigned x, unsigned G, unsigned& nloc, unsigned& nx) {
  unsigned sum, cnt, mine, sp = 0u;
  for (;;) {
    sum = 0u; cnt = 0u; mine = 0u;
#pragma unroll
    for (unsigned j = 0; j < 16; ++j) { const unsigned c = xb_ld(&bar[XB_XCNT(j)]); sum += c; cnt += (c > 0u) ? 1u : 0u; mine = (j == x) ? c : mine; }
    if (sum == G) break;
    __builtin_amdgcn_s_sleep(1);
    if ((++sp & 255u) == 0u) { if (xb_ld(&bar[XB_TMO])) break; if (sp > XB_SPIN_CAP) { atomicAdd(&bar[XB_TMO], 1u); break; } }
  }
  nloc = mine > 0u ? mine : 1u; nx = cnt > 0u ? cnt : 1u;
}
DEVI void xcd_barrier(const XcdBarrier& b) {
  asm volatile("s_waitcnt vmcnt(0)" ::: "memory");
  __syncthreads();
  if (threadIdx.x == 0) {
    unsigned* bar = b.bar;
    asm volatile("" : "+s"(bar));
    __builtin_amdgcn_s_waitcnt(0);
    unsigned nloc = b.st[0], nx = b.st[1];
    if (nloc == 0u) { xcd_barrier_complete(bar, b.x, b.G, nloc, nx); b.st[0] = nloc; b.st[1] = nx; }
    const unsigned old = xb_add(&bar[XB_XSUB(b.x)], 1u);
    const unsigned gen = old / nloc;
    if (old + 1u == (gen + 1u) * nloc) {
      __builtin_amdgcn_fence(__ATOMIC_RELEASE, "agent");
      asm volatile("s_waitcnt vmcnt(0)" ::: "memory");
      if (nx > 1u) {
        const unsigned og = xb_add(&bar[XB_TOP], 1u);
        const unsigned target = (og / nx + 1u) * nx;
        if (og + 1u != target) XB_SPIN(xb_ld(&bar[XB_TOP]) < target, bar);
      }
      __builtin_amdgcn_fence(__ATOMIC_ACQUIRE, "agent");
      xb_add(&bar[XB_XGEN(b.x)], 1u);
      asm volatile("s_waitcnt vmcnt(0)" ::: "memory");
    } else {
      XB_SPIN(xb_ld(&bar[XB_XGEN(b.x)]) == gen, bar);
      __builtin_amdgcn_fence(__ATOMIC_ACQUIRE, "agent");
      asm volatile("s_waitcnt vmcnt(0)" ::: "memory");
    }
  }
  __syncthreads();
}
DEVI int next_item(unsigned* ctr, char* smem) {
  volatile int* slot = (volatile int*)(smem + 66560);
  __syncthreads();
  if (threadIdx.x == 0) *slot = (int)xb_add(ctr, 1u);
  __syncthreads();
  return *slot;
}

DEVI void gemm128(const u16* __restrict__ A, const long (&aoff)[4], const u16* __restrict__ Bt, long ldb, int n0,
                  int K, char* smem, f32x4 (&acc)[4][4], int ksplit = 1 << 30, long kjump = 0) {
  const int tid = get_tid(), lane = tid & 63, wid = tid >> 6, wr = wid >> 1, wc = wid & 1;
#pragma unroll
  for (int m = 0; m < 4; ++m)
#pragma unroll
    for (int n = 0; n < 4; ++n) acc[m][n] = (f32x4){0.f, 0.f, 0.f, 0.f};
  const int srow = tid >> 3, scp = tid & 7;
  long boff[4];
  int sc[4];
#pragma unroll
  for (int i = 0; i < 4; ++i) {
    const int row = srow + 32 * i;
    sc[i] = (scp ^ ((row >> 1) & 7)) * 8;
    boff[i] = (long)(n0 + row) * ldb;
  }
  const int sw = (lane >> 1) & 7;
  __syncthreads();
#pragma unroll
  for (int i = 0; i < 4; ++i) {
    glds16(A + aoff[i] + sc[i], smem + tid * 16 + i * 4096);
    glds16(Bt + boff[i] + sc[i], smem + 16384 + tid * 16 + i * 4096);
  }
  int cur = 0;
  for (int kt = 0; kt < K; kt += 64) {
    wait_vm0();
    __syncthreads();
    char* SA = smem + cur * 32768;
    char* SB = SA + 16384;
    if (kt + 64 < K) {
      char* NA = smem + (cur ^ 1) * 32768;
#pragma unroll
      for (int i = 0; i < 4; ++i) {
        glds16(A + aoff[i] + kt + 64 + ((kt + 64 >= ksplit) ? kjump : 0) + sc[i], NA + tid * 16 + i * 4096);
        glds16(Bt + boff[i] + kt + 64 + sc[i], NA + 16384 + tid * 16 + i * 4096);
      }
    }
#pragma unroll
    for (int ks = 0; ks < 2; ++ks) {
      bf8 af[4], bfr[4];
      const int c = ((ks * 4 + (lane >> 4)) ^ sw) << 4;
#pragma unroll
      for (int m = 0; m < 4; ++m) af[m] = *(const bf8*)(SA + (wr * 64 + m * 16 + (lane & 15)) * 128 + c);
#pragma unroll
      for (int n = 0; n < 4; ++n) bfr[n] = *(const bf8*)(SB + (wc * 64 + n * 16 + (lane & 15)) * 128 + c);
      __builtin_amdgcn_s_setprio(1);
#pragma unroll
      for (int m = 0; m < 4; ++m)
#pragma unroll
        for (int n = 0; n < 4; ++n) acc[m][n] = __builtin_amdgcn_mfma_f32_16x16x32_bf16(bfr[n], af[m], acc[m][n], 0, 0, 0);
      __builtin_amdgcn_s_setprio(0);
    }
    cur ^= 1;
  }
}

template <int EPI_ST, class Epi>
DEVI void gemm128_stream(const u16* __restrict__ A, const long (&aoff)[4], const u16* __restrict__ Bt, long ldb, int n0,
                         int ntiles, int K, char* smem, Epi epi) {
  const int tid = get_tid(), lane = tid & 63, wid = tid >> 6, wr = wid >> 1, wc = wid & 1;
  f32x4 acc[4][4];
#pragma unroll
  for (int m = 0; m < 4; ++m)
#pragma unroll
    for (int n = 0; n < 4; ++n) acc[m][n] = (f32x4){0.f, 0.f, 0.f, 0.f};
  const int srow = tid >> 3, scp = tid & 7;
  long boff[4];
  int sc[4];
#pragma unroll
  for (int i = 0; i < 4; ++i) {
    const int row = srow + 32 * i;
    sc[i] = (scp ^ ((row >> 1) & 7)) * 8;
    boff[i] = (long)(n0 + row) * ldb;
  }
  const int sw = (lane >> 1) & 7;
  const int ksteps = K >> 6, total = ntiles * ksteps;
  __syncthreads();
#pragma unroll
  for (int i = 0; i < 4; ++i) {
    glds16(A + aoff[i] + sc[i], smem + tid * 16 + i * 4096);
    glds16(Bt + boff[i] + sc[i], smem + 16384 + tid * 16 + i * 4096);
  }
  int cur = 0, ks = 0, tile = 0;
  bool after_epi = false;
  for (int st = 0; st < total; ++st) {
    if (EPI_ST > 0 && after_epi) {
      asm volatile("s_waitcnt vmcnt(%0)" ::"n"(EPI_ST) : "memory");
      asm volatile("s_waitcnt lgkmcnt(0)" ::: "memory");
      __builtin_amdgcn_s_barrier();
    } else {
      wait_vm0();
      __syncthreads();
    }
    after_epi = false;
    char* SA = smem + cur * 32768;
    char* SB = SA + 16384;
    if (st + 1 < total) {
      int nks = ks + 1, ntile = tile;
      if (nks == ksteps) { nks = 0; ++ntile; }
      char* NA = smem + (cur ^ 1) * 32768;
      const long bo = (long)ntile * 128 * ldb + nks * 64;
#pragma unroll
      for (int i = 0; i < 4; ++i) {
        glds16(A + aoff[i] + nks * 64 + sc[i], NA + tid * 16 + i * 4096);
        glds16(Bt + boff[i] + bo + sc[i], NA + 16384 + tid * 16 + i * 4096);
      }
    }
#pragma unroll
    for (int k2 = 0; k2 < 2; ++k2) {
      bf8 af[4], bfr[4];
      const int c = ((k2 * 4 + (lane >> 4)) ^ sw) << 4;
#pragma unroll
      for (int m = 0; m < 4; ++m) af[m] = *(const bf8*)(SA + (wr * 64 + m * 16 + (lane & 15)) * 128 + c);
#pragma unroll
      for (int n = 0; n < 4; ++n) bfr[n] = *(const bf8*)(SB + (wc * 64 + n * 16 + (lane & 15)) * 128 + c);
      __builtin_amdgcn_s_setprio(1);
#pragma unroll
      for (int m = 0; m < 4; ++m)
#pragma unroll
        for (int n = 0; n < 4; ++n) acc[m][n] = __builtin_amdgcn_mfma_f32_16x16x32_bf16(bfr[n], af[m], acc[m][n], 0, 0, 0);
      __builtin_amdgcn_s_setprio(0);
    }
    cur ^= 1;
    if (++ks == ksteps) {
      after_epi = epi(tile, acc);
#pragma unroll
      for (int m = 0; m < 4; ++m)
#pragma unroll
        for (int n = 0; n < 4; ++n) acc[m][n] = (f32x4){0.f, 0.f, 0.f, 0.f};
      ks = 0;
      ++tile;
    }
  }
}

typedef unsigned char u8;
constexpr float F8_SW = 32.f;
constexpr float F8_SH = 4.f;
constexpr float F8_SY = 64.f;
constexpr float F8_SO = 16.f;
DEVI unsigned pk4_f8(float a, float b, float c, float d) {
  int w = 0;
  w = __builtin_amdgcn_cvt_pk_fp8_f32(a, b, w, false);
  w = __builtin_amdgcn_cvt_pk_fp8_f32(c, d, w, true);
  return (unsigned)w;
}
DEVI unsigned pk4_f8c(float a, float b, float c, float d) {
  return pk4_f8(__builtin_amdgcn_fmed3f(a, -448.f, 448.f), __builtin_amdgcn_fmed3f(b, -448.f, 448.f),
                __builtin_amdgcn_fmed3f(c, -448.f, 448.f), __builtin_amdgcn_fmed3f(d, -448.f, 448.f));
}
using i32x4 = __attribute__((ext_vector_type(4))) int;
using i32x8 = __attribute__((ext_vector_type(8))) int;
constexpr int MX_ONE = 0x7F7F7F7F;
DEVI i32x8 lds_frag32(const char* base, int o0, int o1) {
  const i32x4 lo = *(const i32x4*)(base + o0);
  const i32x4 hi = *(const i32x4*)(base + o1);
  return (i32x8){lo[0], lo[1], lo[2], lo[3], hi[0], hi[1], hi[2], hi[3]};
}
DEVI void gemm128_f8(const u8* __restrict__ A, const long (&aoff)[4], const u8* __restrict__ Bt, long ldb, int n0,
                     int K, char* smem, f32x4 (&acc)[4][4], bool swp = false) {
  const int tid = get_tid(), lane = tid & 63, wid = tid >> 6, wr = wid >> 1, wc = wid & 1;
#pragma unroll
  for (int m = 0; m < 4; ++m)
#pragma unroll
    for (int n = 0; n < 4; ++n) acc[m][n] = (f32x4){0.f, 0.f, 0.f, 0.f};
  const int srow = tid >> 3, scp = tid & 7;
  int va[4], vb[4];
#pragma unroll
  for (int i = 0; i < 4; ++i) {
    const int row = srow + 32 * i;
    const int sc = (scp ^ ((row >> 1) & 5)) * 16;
    va[i] = (int)aoff[i] + sc;
    vb[i] = (int)((long)(n0 + row) * ldb) + sc;
  }
  const __amdgpu_buffer_rsrc_t rsA = __builtin_amdgcn_make_buffer_rsrc((void*)A, 0, 0x7fffffff, 0x00020000);
  const __amdgpu_buffer_rsrc_t rsB = __builtin_amdgcn_make_buffer_rsrc((void*)Bt, 0, 0x7fffffff, 0x00020000);
  LAS char* const ldsw = (LAS char*)smem + __builtin_amdgcn_readfirstlane(wid * 1024);
  const int g = lane >> 4;
  const int fo = (lane & 15) * 128 + (((2 * g) ^ ((lane >> 1) & 5)) << 4);
  const int fo1 = fo ^ 16;
  __syncthreads();
#pragma unroll
  for (int i = 0; i < 4; ++i) {
    __builtin_amdgcn_raw_ptr_buffer_load_lds(rsA, (LAS void*)(ldsw + i * 4096), 16, va[i], 0, 0, 0);
    __builtin_amdgcn_raw_ptr_buffer_load_lds(rsB, (LAS void*)(ldsw + 16384 + i * 4096), 16, vb[i], 0, 0, 0);
  }
  int cur = 0;
#pragma unroll 1
  for (int kt = 0; kt < K; kt += 128) {
    wait_vm0();
    __syncthreads();
    char* SA = smem + cur * 32768;
    char* SB = SA + 16384;
    if (kt + 128 < K) {
      LAS char* NA = ldsw + (cur ^ 1) * 32768;
#pragma unroll
      for (int i = 0; i < 4; ++i) {
        __builtin_amdgcn_raw_ptr_buffer_load_lds(rsA, (LAS void*)(NA + i * 4096), 16, va[i], kt + 128, 0, 0);
        __builtin_amdgcn_raw_ptr_buffer_load_lds(rsB, (LAS void*)(NA + 16384 + i * 4096), 16, vb[i], kt + 128, 0, 0);
      }
    }
    {
      __builtin_amdgcn_sched_barrier(0);
      i32x8 bfr[4];
#pragma unroll
      for (int n = 0; n < 4; ++n) bfr[n] = lds_frag32(SB + (wc * 64 + n * 16) * 128, fo, fo1);
      i32x8 af[4];
#pragma unroll
      for (int m = 0; m < 4; ++m) af[m] = lds_frag32(SA + (wr * 64 + m * 16) * 128, fo, fo1);
      __builtin_amdgcn_sched_barrier(0);
      if (!swp) {
#pragma unroll
        for (int m = 0; m < 4; ++m)
#pragma unroll
          for (int n = 0; n < 4; ++n)
            acc[m][n] = __builtin_amdgcn_mfma_scale_f32_16x16x128_f8f6f4(bfr[n], af[m], acc[m][n], 0, 0, 0, MX_ONE, 0, MX_ONE);
      } else {
#pragma unroll
        for (int m = 0; m < 4; ++m)
#pragma unroll
          for (int n = 0; n < 4; ++n)
            acc[m][n] = __builtin_amdgcn_mfma_scale_f32_16x16x128_f8f6f4(af[m], bfr[n], acc[m][n], 0, 0, 0, MX_ONE, 0, MX_ONE);
      }
      __builtin_amdgcn_sched_barrier(0);
    }
    cur ^= 1;
  }
}

template <int EPI_ST, class Epi>
DEVI void gemm128_stream_f8(const u8* __restrict__ A, const long (&aoff)[4], const u8* __restrict__ Bt, long ldb, int n0,
                            int ntiles, int K, char* smem, Epi epi) {
  const int tid = get_tid(), lane = tid & 63, wid = tid >> 6, wr = wid >> 1, wc = wid & 1;
  f32x4 acc[4][4];
#pragma unroll
  for (int m = 0; m < 4; ++m)
#pragma unroll
    for (int n = 0; n < 4; ++n) acc[m][n] = (f32x4){0.f, 0.f, 0.f, 0.f};
  const int srow = tid >> 3, scp = tid & 7;
  long boff[4];
  int sc[4];
#pragma unroll
  for (int i = 0; i < 4; ++i) {
    const int row = srow + 32 * i;
    sc[i] = (scp ^ ((row >> 1) & 5)) * 16;
    boff[i] = (long)(n0 + row) * ldb;
  }
  const int g = lane >> 4;
  const int fo = (lane & 15) * 128 + (((2 * g) ^ ((lane >> 1) & 5)) << 4);
  const int fo1 = fo ^ 16;
  const int ksteps = K >> 7, total = ntiles * ksteps;
  __syncthreads();
#pragma unroll
  for (int i = 0; i < 4; ++i) {
    glds16(A + aoff[i] + sc[i], smem + tid * 16 + i * 4096);
    glds16(Bt + boff[i] + sc[i], smem + 32768 + tid * 16 + i * 4096);
  }
#pragma unroll
  for (int i = 0; i < 4; ++i) glds16(A + aoff[i] + 128 + sc[i], smem + 16384 + tid * 16 + i * 4096);
  int cur = 0, ks = 0, tile = 0;
  bool after_epi = false;
  for (int st = 0; st < total; ++st) {
    if (EPI_ST > 0 && after_epi) {
      asm volatile("s_waitcnt vmcnt(%0)" ::"n"(EPI_ST) : "memory");
      asm volatile("s_waitcnt lgkmcnt(0)" ::: "memory");
      __builtin_amdgcn_s_barrier();
    } else {
      wait_vm0();
      __syncthreads();
    }
    after_epi = false;
    char* SA = smem + ks * 16384;
    char* SB = smem + 32768 + cur * 16384;
    if (st + 1 < total) {
      int nks = ks + 1, ntile = tile;
      if (nks == ksteps) { nks = 0; ++ntile; }
      char* NB = smem + 32768 + (cur ^ 1) * 16384;
      const long bo = (long)ntile * 128 * ldb + nks * 128;
#pragma unroll
      for (int i = 0; i < 4; ++i) glds16(Bt + boff[i] + bo + sc[i], NB + tid * 16 + i * 4096);
    }
    {
      __builtin_amdgcn_sched_barrier(0);
      i32x8 bfr[4];
#pragma unroll
      for (int n = 0; n < 4; ++n) bfr[n] = lds_frag32(SB + (wc * 64 + n * 16) * 128, fo, fo1);
      i32x8 af[4];
#pragma unroll
      for (int m = 0; m < 4; ++m) af[m] = lds_frag32(SA + (wr * 64 + m * 16) * 128, fo, fo1);
      __builtin_amdgcn_sched_barrier(0);
#pragma unroll
      for (int m = 0; m < 4; ++m)
#pragma unroll
        for (int n = 0; n < 4; ++n)
          acc[m][n] = __builtin_amdgcn_mfma_scale_f32_16x16x128_f8f6f4(bfr[n], af[m], acc[m][n], 0, 0, 0, MX_ONE, 0, MX_ONE);
      __builtin_amdgcn_sched_barrier(0);
    }
    cur ^= 1;
    if (++ks == ksteps) {
      after_epi = epi(tile, acc);
#pragma unroll
      for (int m = 0; m < 4; ++m)
#pragma unroll
        for (int n = 0; n < 4; ++n) acc[m][n] = (f32x4){0.f, 0.f, 0.f, 0.f};
      ks = 0;
      ++tile;
    }
  }
}

template <bool F8 = false, class CP>
DEVI void cvt_tile(CP colptr, int ld, int k0, u16* __restrict__ dst, int dstK, int nrow0, char* smem) {
  float* tile = (float*)smem;
  const int tid = get_tid(), n = tid & 31, kk = tid >> 5;
  const float* cp = colptr(nrow0 + n);
#pragma unroll
  for (int i = 0; i < 8; ++i) {
    const int k = kk + 8 * i;
    tile[n * 65 + k] = cp ? cp[(long)(k0 + k) * ld] : 0.f;
  }
  __syncthreads();
  const int r = tid >> 3, c8 = (tid & 7) * 8;
  const float* tp = tile + r * 65 + c8;
  if (F8) {
    *(uint2*)((u8*)dst + (long)(nrow0 + r) * dstK + k0 + c8) =
        make_uint2(pk4_f8(tp[0] * F8_SW, tp[1] * F8_SW, tp[2] * F8_SW, tp[3] * F8_SW), pk4_f8(tp[4] * F8_SW, tp[5] * F8_SW, tp[6] * F8_SW, tp[7] * F8_SW));
  } else {
    uint4 v;
    v.x = pk2(tp[0], tp[1]); v.y = pk2(tp[2], tp[3]); v.z = pk2(tp[4], tp[5]); v.w = pk2(tp[6], tp[7]);
    *(uint4*)(dst + (long)(nrow0 + r) * dstK + k0 + c8) = v;
  }
  __syncthreads();
}

template <class PERM>
DEVI void cvt64(const float* __restrict__ srcA, const float* __restrict__ srcB, int ld, int k0, u16* __restrict__ dst, int dstK,
                int nrow0, PERM perm, char* smem) {
  float* tile = (float*)smem;
  const int tid = get_tid();
  {
    const int c4 = (tid & 15) * 4, kr = tid >> 4;
    const float* sp = c4 < 32 ? srcA + c4 : srcB + (c4 - 32);
#pragma unroll
    for (int i = 0; i < 4; ++i) {
      const int k = kr + 16 * i;
      const float4 v = *(const float4*)(sp + (long)(k0 + k) * ld);
      float* tp = tile + k * 65 + c4;
      tp[0] = v.x; tp[1] = v.y; tp[2] = v.z; tp[3] = v.w;
    }
  }
  __syncthreads();
  {
    const int r = tid >> 2, kc = (tid & 3) * 16;
    const float* tp = tile + kc * 65 + perm(r);
    uint4 v0, v1;
    v0.x = pk2(tp[0], tp[65]); v0.y = pk2(tp[130], tp[195]); v0.z = pk2(tp[260], tp[325]); v0.w = pk2(tp[390], tp[455]);
    v1.x = pk2(tp[520], tp[585]); v1.y = pk2(tp[650], tp[715]); v1.z = pk2(tp[780], tp[845]); v1.w = pk2(tp[910], tp[975]);
    u16* dp = dst + (long)(nrow0 + r) * dstK + k0 + kc;
    *(uint4*)dp = v0;
    *(uint4*)(dp + 8) = v1;
  }
  __syncthreads();
}
DEVI int perm16(int c) { return 16 * ((c >> 2) & 3) + 4 * (c >> 4) + (c & 3); }
struct CvtJob { const float* sp; long rstride; u8* dp; int permflag; };
DEVI void cvt64_load(const CvtJob& j, float4 (&v)[4]) {
#pragma unroll
  for (int i = 0; i < 4; ++i) v[i] = *(const float4*)(j.sp + (long)(16 * i) * j.rstride);
}
DEVI void lds_barrier() {
  asm volatile("s_waitcnt lgkmcnt(0)" ::: "memory");
  __builtin_amdgcn_s_barrier();
}
DEVI void cvt64_store(const CvtJob& j, const float4 (&v)[4], char* smem) {
  float* tile = (float*)smem;
  const int tid = get_tid();
  {
    const int c4 = (tid & 15) * 4, kr = tid >> 4;
#pragma unroll
    for (int i = 0; i < 4; ++i) {
      float* tp = tile + (kr + 16 * i) * 65 + c4;
      tp[0] = v[i].x; tp[1] = v[i].y; tp[2] = v[i].z; tp[3] = v[i].w;
    }
  }
  lds_barrier();
  {
    const int r = tid >> 2, kc = (tid & 3) * 16;
    const float* tp = tile + kc * 65 + (j.permflag == 1 ? perm16(r) : j.permflag == 2 ? ((r & 32) | (((r >> 2) & 3) << 3) | (((r >> 4) & 1) << 2) | (r & 3)) : r);
    uint4 v0;
    v0.x = pk4_f8(tp[0] * F8_SW, tp[65] * F8_SW, tp[130] * F8_SW, tp[195] * F8_SW);
    v0.y = pk4_f8(tp[260] * F8_SW, tp[325] * F8_SW, tp[390] * F8_SW, tp[455] * F8_SW);
    v0.z = pk4_f8(tp[520] * F8_SW, tp[585] * F8_SW, tp[650] * F8_SW, tp[715] * F8_SW);
    v0.w = pk4_f8(tp[780] * F8_SW, tp[845] * F8_SW, tp[910] * F8_SW, tp[975] * F8_SW);
    *(uint4*)j.dp = v0;
  }
  lds_barrier();
}
DEVI CvtJob cvt64_job(const float* srcA, const float* srcB, int ld, int k0, u8* dst, int dstK, int nrow0, int permflag, int tid) {
  CvtJob j;
  const int c4 = (tid & 15) * 4, kr = tid >> 4;
  j.sp = (c4 < 32 ? srcA + c4 : srcB + (c4 - 32)) + (long)(k0 + kr) * ld;
  j.rstride = ld;
  j.dp = dst + (long)(nrow0 + (tid >> 2)) * dstK + k0 + (tid & 3) * 16;
  j.permflag = permflag;
  return j;
}

DEVI bool chunk_is_tr(int j) { return (j >= 8 && j <= 11) || j == 24 || j == 25 || j == 28 || j == 29 || j == 37; }
DEVI int win_rowperm(int np) {
  const int j = np >> 6, r = np & 63;
  if (j >= 43 || chunk_is_tr(j)) return np;
  const int n = r >> 4, g = (r >> 2) & 3, q = r & 3;
  return (np & ~63) | ((n & 2) * 16 + 8 * g + 4 * (n & 1) + q);
}
DEVI int win_srccol(int np) {
  const int j = np >> 6, d = np & 63;
  if (j < 12) return 64 * j + d;
  if (j < 30) return 772 + 64 * (j - 12) + d;
  if (j < 43) return 1942 + 64 * (j - 30) + d;
  if (d < 4) return 768 + d;
  if (d < 22) return 1924 + (d - 4);
  if (d < 26) return 2774 + (d - 22);
  return -1;
}

DEVI void phase_prep(const Params& p, char* smem) {
  const int tid = get_tid();
  u16* WIN = (u16*)(p.ws + OFF_WIN);
  u16* WO = (u16*)(p.ws + OFF_WO);
  u16* WC1 = (u16*)(p.ws + OFF_WC1);
  float2* ROPE = (float2*)(p.ws + OFF_ROPE);
  u16* XB = (u16*)(p.ws + OFF_XB);
  unsigned* CNT = (unsigned*)(p.ws + OFF_CNT);
  constexpr int N_WIN = NL * 88 * 16, N_WO = NL * 16 * 16, N_WC1 = NL * 2 * 4 * 32, N_CB = NL * 2 * 8, N_ROPE = 256,
                N_XB = NTOK * DM / 16384, N_WR = NL * 128, N_Z = 1;
  constexpr int TOT = N_WIN + N_WO + N_WC1 + N_CB + N_ROPE + N_XB + N_WR + N_Z;
  u16* WR2 = (u16*)(p.ws + OFF_WR2);
  float* CBP = (float*)(p.ws + OFF_CBP);
  int it = blockIdx.x;
  {
    const int n = tid & 31, kk = tid >> 5;
    const int r = tid >> 3, c8 = (tid & 7) * 8;
    float* tile = (float*)smem;
#define PW_LOAD(V, IT)                                                                      \
  {                                                                                         \
    const int l_ = (IT) / (88 * 16), r_ = (IT) % (88 * 16), grp_ = r_ / 16, kt_ = r_ % 16;   \
    const int c_ = win_srccol(win_rowperm(grp_ * 32 + n));                                   \
    const float* cp_ = p.in[1] + (size_t)l_ * DM * NIN + (c_ >= 0 ? c_ : 0);                 \
    _Pragma("unroll") for (int i_ = 0; i_ < 8; ++i_) {                                       \
      const float t_ = cp_[(long)(kt_ * 64 + kk + 8 * i_) * NIN];                            \
      V[i_] = c_ >= 0 ? t_ : 0.f;                                                            \
    }                                                                                        \
  }
#define PW_STORE(V, IT)                                                                     \
  {                                                                                         \
    const int l_ = (IT) / (88 * 16), r_ = (IT) % (88 * 16), grp_ = r_ / 16, kt_ = r_ % 16;   \
    _Pragma("unroll") for (int i_ = 0; i_ < 8; ++i_) tile[n * 65 + kk + 8 * i_] = V[i_];     \
    lds_barrier();                                                                           \
    const float* tp_ = tile + r * 65 + c8;                                                   \
    *(uint2*)((u8*)WIN + (size_t)l_ * NPAD * DM + (long)(grp_ * 32 + r) * DM + kt_ * 64 + c8) = \
        make_uint2(pk4_f8(tp_[0] * F8_SW, tp_[1] * F8_SW, tp_[2] * F8_SW, tp_[3] * F8_SW),    \
                   pk4_f8(tp_[4] * F8_SW, tp_[5] * F8_SW, tp_[6] * F8_SW, tp_[7] * F8_SW));    \
    lds_barrier();                                                                           \
  }
    const int gd = gridDim.x;
    float w0[8], w1[8], w2[8];
    if (it < N_WIN) PW_LOAD(w0, it)
    if (it + gd < N_WIN) PW_LOAD(w1, it + gd)
#pragma unroll 1
    for (; it < N_WIN; it += gd) {
      if (it + 2 * gd < N_WIN) PW_LOAD(w2, it + 2 * gd)
      PW_STORE(w0, it)
#pragma unroll
      for (int q = 0; q < 8; ++q) { w0[q] = w1[q]; w1[q] = w2[q]; }
    }
#undef PW_LOAD
#undef PW_STORE
    __syncthreads();
  }
  for (; it < TOT; it += gridDim.x) {
    int i = it;
    i -= N_WIN;
    if (i < N_WO) {
      const int l = i / 256, r = i % 256, grp = r / 16, kt = r % 16;
      const float* src = p.in[9] + (size_t)l * DM * DM + grp * 64;
      const CvtJob job = cvt64_job(src, src + 32, DM, kt * 64, (u8*)WO + (size_t)l * DM * DM, DM, grp * 64, 1, tid);
      float4 cv[4];
      cvt64_load(job, cv);
      cvt64_store(job, cv, smem);
      __syncthreads();
      continue;
    }
    i -= N_WO;
    if (i < N_WC1) {
      const int lk = i / 128, r = i % 128, grp = r / 32, kt = r % 32;
      const int l = lk >> 1, kv = lk & 1;
      const float* src = p.in[kv ? 7 : 4] + (size_t)l * 2048 * 128;
      cvt_tile([&](int np) -> const float* { return src + np; }, 128, kt * 64, WC1 + (size_t)lk * 128 * 2048, 2048, grp * 32, smem);
      continue;
    }
    i -= N_WC1;
    if (i < N_CB) {
      const int lk = i >> 3, ch = i & 7, l = lk >> 1, kv = lk & 1;
      const float* pe = p.in[kv ? 6 : 3] + (size_t)l * 2048 + ch * 256;
      const float* w1 = p.in[kv ? 7 : 4] + (size_t)l * 2048 * 128 + (size_t)ch * 256 * 128;
      const int j = tid & 127, half = tid >> 7;
      float a = 0.f;
#pragma unroll 16
      for (int k = half * 128; k < half * 128 + 128; ++k) a += pe[k] * w1[(size_t)k * 128 + j];
      float* red = (float*)smem;
      if (half) red[j] = a;
      __syncthreads();
      if (!half) CBP[(size_t)i * 128 + j] = a + red[j];
      __syncthreads();
      continue;
    }
    i -= N_CB;
    if (i < N_ROPE) {
      const int idx = i * 256 + tid;
      const int t = idx >> 5, f = idx & 31;
      const double inv = pow(10000.0, -(double)f / 32.0);
      const double ang = (double)t * inv;
      ROPE[idx] = make_float2((float)cos(ang), (float)sin(ang));
      continue;
    }
    i -= N_ROPE;
    if (i < N_XB) {
      const float* x = p.in[0] + (size_t)i * 16384;
      u8* d = (u8*)(p.ws + OFF_XA + (32u << 20)) + (size_t)i * 16384;
      float4 v[16];
#pragma unroll
      for (int j = 0; j < 16; ++j) v[j] = *(const float4*)(x + (j * 256 + tid) * 4);
#pragma unroll
      for (int j = 0; j < 16; ++j) *(unsigned*)(d + (j * 256 + tid) * 4) = pk4_f8c(v[j].x, v[j].y, v[j].z, v[j].w);
      continue;
    }
    i -= N_XB;
    if (i < N_WR) {
      const int l = i >> 7, r = i & 127, wcs = r >> 6, within = r & 63, e = wcs * 32 + (within & 31);
      const float* wsrc = p.in[12] + (size_t)l * DM * NE + e;
      u16* d = WR2 + (size_t)l * 128 * 2048 + ((size_t)(r >> 5) * 64 + (r & 31)) * 8;
#pragma unroll
      for (int q = 0; q < 4; ++q) {
        const int k = tid + 256 * q;
        const float wv = wsrc[(size_t)k * NE];
        const u16 hi = f2bf(wv);
        const u16 lo = f2bf(wv - bf2f(hi));
        const size_t o = (size_t)(k >> 4) * 2048 + ((k >> 3) & 1) * 256 + (k & 7);
        d[o] = within < 32 ? hi : lo;
        d[o + (size_t)64 * 2048] = within < 32 ? hi : (u16)0;
      }
      continue;
    }
    i -= N_WR;
    { for (int j = tid; j < NL * 128; j += 256) CNT[j] = 0u; }
  }
}

#define XCD_LOOP(it, n)                                                            \
  for (int it = ((blockIdx.x & 7) * (((n) + 7) >> 3)) + (blockIdx.x >> 3),         \
           it##_end = min((int)(n), ((blockIdx.x & 7) + 1) * (((n) + 7) >> 3));   \
       it < it##_end; it += (gridDim.x >> 3))

DEVI void inproj_epilogue(const Params& p, f32x4 (&acc)[4][4], int m0, int n0) {
  const int tid = get_tid(), lane = tid & 63, wid = tid >> 6, wr = wid >> 1, wc = wid & 1;
  const int j = (n0 >> 6) + wc;
  const float2* ROPE = (const float2*)(p.ws + OFF_ROPE);
  u16* CH = (u16*)(p.ws + OFF_CH);
  float* MISC = (float*)(p.ws + OFF_MISC);
  const bool rope = (j >= 12 && j <= 19) || j == 22 || j == 23 || j == 26 || j == 27 || (j >= 30 && j <= 36) ||
                    (j >= 38 && j <= 42);
  const bool qs = (j < 4) || (j >= 12 && j <= 17) || (j >= 30 && j <= 35);
  const float scl = qs ? QSCALE : 1.f;
  const int g = lane >> 4;
  if (chunk_is_tr(j)) {
    const int tok0 = m0 + wr * 64, b = tok0 >> 11, t0 = tok0 & 2047;
    u16* o = CH + (size_t)j * CHSZ + (size_t)b * 64 * T_ + t0 + 4 * (g & ~1);
#pragma unroll
    for (int m = 0; m < 4; ++m)
#pragma unroll
      for (int np = 0; np < 2; ++np) {
        const uint2 a = pk4(acc[m][2 * np][0], acc[m][2 * np][1], acc[m][2 * np][2], acc[m][2 * np][3]);
        const uint2 c = pk4(acc[m][2 * np + 1][0], acc[m][2 * np + 1][1], acc[m][2 * np + 1][2], acc[m][2 * np + 1][3]);
        const auto r0 = __builtin_amdgcn_permlane16_swap(a.x, c.x, false, false);
        const auto r1 = __builtin_amdgcn_permlane16_swap(a.y, c.y, false, false);
        const int n = 2 * np + (g & 1);
        *(uint4*)(o + (size_t)(n * 16 + (lane & 15)) * T_ + m * 16) = make_uint4(r0[0], r1[0], r0[1], r1[1]);
      }
    return;
  }
#pragma unroll
  for (int m = 0; m < 4; ++m) {
    const int tok = m0 + wr * 64 + m * 16 + (lane & 15);
    const int t = tok & 2047;
    if (j == CH_MISC) {
#pragma unroll
      for (int n = 0; n < 2; ++n) *(f32x4*)(MISC + (size_t)tok * 32 + n * 16 + 4 * g) = acc[m][n];
      continue;
    }
    float y[4][4];
#pragma unroll
    for (int n = 0; n < 2; ++n) {
      f32x4 c0 = {1.f, 0.f, 1.f, 0.f}, c1 = {1.f, 0.f, 1.f, 0.f};
      if (rope) {
        const f32x4* rp = (const f32x4*)(ROPE + t * 32 + 8 * g + 4 * n);
        c0 = rp[0]; c1 = rp[1];
      }
      const float cs[4] = {c0[0], c0[2], c1[0], c1[2]}, sn[4] = {c0[1], c0[3], c1[1], c1[3]};
#pragma unroll
      for (int q = 0; q < 4; ++q) {
        const float x1 = acc[m][n][q], x2 = acc[m][n + 2][q];
        y[n][q] = (x1 * cs[q] - x2 * sn[q]) * scl;
        y[n + 2][q] = (x2 * cs[q] + x1 * sn[q]) * scl;
      }
    }
    u16* o = CH + (size_t)j * CHSZ + (size_t)tok * 64 + 8 * g;
    {
      const uint2 a0 = pk4(y[0][0], y[0][1], y[0][2], y[0][3]), a1 = pk4(y[1][0], y[1][1], y[1][2], y[1][3]);
      const uint2 b0 = pk4(y[2][0], y[2][1], y[2][2], y[2][3]), b1 = pk4(y[3][0], y[3][1], y[3][2], y[3][3]);
      *(uint4*)o = make_uint4(a0.x, a0.y, a1.x, a1.y);
      *(uint4*)(o + 32) = make_uint4(b0.x, b0.y, b1.x, b1.y);
    }
  }
}

DEVI void phase_inproj(const Params& p, int l, char* smem) {
  const int tid = get_tid();
  const u8* XB = (const u8*)(p.ws + OFF_XA + (32u << 20));
  const u8* WIN = (const u8*)(p.ws + OFF_WIN) + (size_t)l * NPAD * DM;
  u8* WGU = (u8*)(p.ws + OFF_WGU);
  u8* WD = (u8*)(p.ws + OFF_WD);
  constexpr int N_G = 128 * 22, N_GU = 65 * 8 * 16, N_D = 65 * 16 * 4, N_C = N_GU + N_D;
  auto make_job = [&](int i) -> CvtJob {
    if (i < N_GU) {
      const int e = i / 128, r = i % 128, grp = r / 16, kt = r % 16;
      const float* sg = (e < 64) ? p.in[14] + ((size_t)l * 64 + e) * DM * EH : p.in[17] + (size_t)l * DM * EH;
      const float* su = (e < 64) ? p.in[15] + ((size_t)l * 64 + e) * DM * EH : p.in[18] + (size_t)l * DM * EH;
      return cvt64_job(sg + grp * 32, su + grp * 32, EH, kt * 64, WGU + (size_t)e * 512 * DM, DM, grp * 64, 2, tid);
    } else {
      const int i2 = i - N_GU;
      const int e = i2 / 64, r = i2 % 64, grp = r / 4, kt = r % 4;
      const float* src = ((e < 64) ? p.in[16] + ((size_t)l * 64 + e) * EH * DM : p.in[19] + (size_t)l * EH * DM) + grp * 64;
      return cvt64_job(src, src + 32, DM, kt * 64, WD + (size_t)e * DM * EH, EH, grp * 64, 1, tid);
    }
  };
  const int it_first = ((blockIdx.x & 7) * ((N_G + 7) >> 3)) + (blockIdx.x >> 3);
  const int it_end = min(N_G, (int)((blockIdx.x & 7) + 1) * ((N_G + 7) >> 3));
  const int it_step = gridDim.x >> 3;
  const bool gemm_first = ((blockIdx.x >> 3) & 1) == 0;
#pragma unroll 1
  for (int pass = 0; pass < 2; ++pass) {
    if ((pass == 0) == gemm_first) {
#pragma unroll 1
      for (int it = it_first; it < it_end; it += it_step) {
        const int mt = it / 22, nt = it % 22;
        long aoff[4];
#pragma unroll
        for (int q = 0; q < 4; ++q) aoff[q] = (long)(mt * 128 + (tid >> 3) + 32 * q) * DM;
        f32x4 acc[4][4];
        gemm128_f8(XB, aoff, WIN, DM, nt * 128, DM, smem, acc, chunk_is_tr(nt * 2 + ((tid >> 6) & 1)));
#pragma unroll
        for (int m_ = 0; m_ < 4; ++m_)
#pragma unroll
          for (int n_ = 0; n_ < 4; ++n_) acc[m_][n_] *= (1.f / F8_SW);
        inproj_epilogue(p, acc, mt * 128, nt * 128);
      }
      __syncthreads();
    } else if (it_first < it_end) {
      int jit = it_first, ji = (int)((long)jit * N_C / N_G), je = (int)((long)(jit + 1) * N_C / N_G);
      bool jok = true;
#define IP_NEXT()                                                        \
  {                                                                      \
    if (++ji == je) {                                                    \
      jit += it_step;                                                    \
      ji = (int)((long)jit * N_C / N_G);                                 \
      je = (int)((long)(jit + 1) * N_C / N_G);                           \
      jok = jit < it_end;                                                \
    }                                                                    \
  }
      CvtJob j0 = make_job(ji), j1 = j0, j2 = j0, j3 = j0;
      float4 v0[4], v1[4], v2[4], v3[4];
      bool ok1 = false, ok2 = false, ok3 = false;
      cvt64_load(j0, v0);
      IP_NEXT()
      if (jok) { j1 = make_job(ji); cvt64_load(j1, v1); ok1 = true; IP_NEXT() }
      if (jok && ok1) { j2 = make_job(ji); cvt64_load(j2, v2); ok2 = true; IP_NEXT() }
#pragma unroll 1
      while (true) {
        ok3 = false;
        if (jok && ok2) { j3 = make_job(ji); cvt64_load(j3, v3); ok3 = true; IP_NEXT() }
        cvt64_store(j0, v0, smem);
        if (!ok1) break;
        j0 = j1; j1 = j2; j2 = j3;
#pragma unroll
        for (int q = 0; q < 4; ++q) { v0[q] = v1[q]; v1[q] = v2[q]; v2[q] = v3[q]; }
        ok1 = ok2; ok2 = ok3;
      }
#undef IP_NEXT
      __syncthreads();
    }
  }
}

DEVI void gemm32_direct(const u16* __restrict__ arow, const u16* __restrict__ brow, int K, f32x16& acc, int h) {
  arow += 8 * h;
  brow += 8 * h;
#pragma unroll 2
  for (int k0 = 0; k0 < K; k0 += 64) {
    bf8 a[4], b[4];
#pragma unroll
    for (int s = 0; s < 4; ++s) { a[s] = *(const bf8*)(arow + k0 + 16 * s); b[s] = *(const bf8*)(brow + k0 + 16 * s); }
#pragma unroll
    for (int s = 0; s < 4; ++s) acc = __builtin_amdgcn_mfma_f32_32x32x16_bf16(a[s], b[s], acc, 0, 0, 0);
  }
}

DEVI void gemm32x128_ksplit(const u16* __restrict__ arow, const u16* __restrict__ bt, long ldb, int K, float* out, int wid, int lane) {
  const int h = lane >> 5;
  const int kq = K >> 2;
  f32x16 acc[4];
#pragma unroll
  for (int c = 0; c < 4; ++c)
#pragma unroll
    for (int r = 0; r < 16; ++r) acc[c][r] = 0.f;
  const u16* ap = arow + wid * kq + 8 * h;
  const u16* bp = bt + (long)(lane & 31) * ldb + wid * kq + 8 * h;
  bf8 a0[2], a1[2], b0[4][2], b1[4][2];
#define KR_LOAD(KK, AA, BB)                                                                          \
  {                                                                                                  \
    _Pragma("unroll") for (int s = 0; s < 2; ++s) AA[s] = *(const bf8*)(ap + (KK) + 16 * s);          \
    _Pragma("unroll") for (int c = 0; c < 4; ++c)                                                     \
      _Pragma("unroll") for (int s = 0; s < 2; ++s) BB[c][s] = *(const bf8*)(bp + (long)c * 32 * ldb + (KK) + 16 * s); \
  }
#define KR_MMA(AA, BB)                                                                               \
  {                                                                                                  \
    _Pragma("unroll") for (int s = 0; s < 2; ++s)                                                     \
      _Pragma("unroll") for (int c = 0; c < 4; ++c)                                                   \
        acc[c] = __builtin_amdgcn_mfma_f32_32x32x16_bf16(AA[s], BB[c][s], acc[c], 0, 0, 0);           \
  }
  KR_LOAD(0, a0, b0)
#pragma unroll 1
  for (int k0 = 0; k0 < kq; k0 += 64) {
    KR_LOAD(k0 + 32, a1, b1)
    __builtin_amdgcn_sched_barrier(0);
    KR_MMA(a0, b0)
    __builtin_amdgcn_sched_barrier(0);
    if (k0 + 64 < kq) KR_LOAD(k0 + 64, a0, b0)
    __builtin_amdgcn_sched_barrier(0);
    KR_MMA(a1, b1)
    __builtin_amdgcn_sched_barrier(0);
  }
#undef KR_LOAD
#undef KR_MMA
#pragma unroll 1
  for (int w = 0; w < 4; ++w) {
    if (wid == w) {
#pragma unroll
      for (int c = 0; c < 4; ++c)
#pragma unroll
        for (int r = 0; r < 16; ++r) {
          float* o = out + ((r & 3) + 8 * (r >> 2) + 4 * h) * 129 + c * 32 + (lane & 31);
          *o = (w == 0) ? acc[c][r] : *o + acc[c][r];
        }
    }
    __syncthreads();
  }
}

DEVI void gemm32x128_ksplit_fm(const u16* __restrict__ xh, const u16* __restrict__ xl, const u16* __restrict__ bfm, float* out, int wid,
                               int lane) {
  const int h = lane >> 5;
  f32x16 acc[4];
#pragma unroll
  for (int c = 0; c < 4; ++c)
#pragma unroll
    for (int r = 0; r < 16; ++r) acc[c][r] = 0.f;
  const u16* apH = (wid < 2 ? xh + 512 * wid : xl + 512 * (wid - 2)) + 8 * h;
  const u16* bpH = bfm + (size_t)(32 * wid) * 2048 + lane * 8;
  const u16* apL = xh + 256 * wid + 8 * h;
  const u16* bpL = bfm + (size_t)(16 * wid) * 2048 + 512 + lane * 8;
  bf8 a0[2], a1[2], b0[2][2], b1[2][2];
#define RS_LOAD(AP, BP, AA, BB)                                                                      \
  {                                                                                                  \
    _Pragma("unroll") for (int s = 0; s < 2; ++s) {                                                  \
      AA[s] = *(const bf8*)((AP) + 16 * s);                                                          \
      _Pragma("unroll") for (int j = 0; j < 2; ++j) BB[j][s] = *(const bf8*)((BP) + s * 2048 + j * 1024); \
    }                                                                                                \
  }
#define RS_MMA(AA, BB, C0, C1)                                                                       \
  {                                                                                                  \
    _Pragma("unroll") for (int s = 0; s < 2; ++s) {                                                  \
      acc[C0] = __builtin_amdgcn_mfma_f32_32x32x16_bf16(AA[s], BB[0][s], acc[C0], 0, 0, 0);          \
      acc[C1] = __builtin_amdgcn_mfma_f32_32x32x16_bf16(AA[s], BB[1][s], acc[C1], 0, 0, 0);          \
    }                                                                                                \
  }
  RS_LOAD(apH, bpH, a0, b0)
#pragma unroll 1
  for (int i = 0; i < 16; i += 2) {
    RS_LOAD(apH + 32 * (i + 1), bpH + 4096 * (i + 1), a1, b1)
    __builtin_amdgcn_sched_barrier(0);
    RS_MMA(a0, b0, 0, 2)
    __builtin_amdgcn_sched_barrier(0);
    if (i + 2 < 16) RS_LOAD(apH + 32 * (i + 2), bpH + 4096 * (i + 2), a0, b0)
    else RS_LOAD(apL, bpL, a0, b0)
    __builtin_amdgcn_sched_barrier(0);
    RS_MMA(a1, b1, 0, 2)
    __builtin_amdgcn_sched_barrier(0);
  }
#pragma unroll 1
  for (int i = 0; i < 8; i += 2) {
    RS_LOAD(apL + 32 * (i + 1), bpL + 4096 * (i + 1), a1, b1)
    __builtin_amdgcn_sched_barrier(0);
    RS_MMA(a0, b0, 1, 3)
    __builtin_amdgcn_sched_barrier(0);
    if (i + 2 < 8) RS_LOAD(apL + 32 * (i + 2), bpL + 4096 * (i + 2), a0, b0)
    __builtin_amdgcn_sched_barrier(0);
    RS_MMA(a1, b1, 1, 3)
    __builtin_amdgcn_sched_barrier(0);
  }
#undef RS_LOAD
#undef RS_MMA
#pragma unroll 1
  for (int w = 0; w < 4; ++w) {
    if (wid == w) {
#pragma unroll
      for (int c = 0; c < 4; ++c)
#pragma unroll
        for (int r = 0; r < 16; ++r) {
          float* o = out + ((r & 3) + 8 * (r >> 2) + 4 * h) * 129 + c * 32 + (lane & 31);
          *o = (w == 0) ? acc[c][r] : *o + acc[c][r];
        }
    }
    __syncthreads();
  }
}

DEVI float gelu_tanh(float x) {
  const float u = 0.7978845608028654f * (x + 0.044715f * x * x * x);
  return 0.5f * x * (1.f + tanhf(u));
}

DEVI void item_s2(const Params& p, int l, int bsel, int it2, char* smem) {
  const int tid = get_tid(), lane = tid & 63, wid = tid >> 6, h = lane >> 5;
  const float* MISC = (const float*)(p.ws + OFF_MISC);
  float* CL = (float*)(p.ws + OFF_CL);
  const u16* CH = (const u16*)(p.ws + OFF_CH);
  const u16* WC1 = (const u16*)(p.ws + OFF_WC1);
  const float* CBP = (const float*)(p.ws + OFF_CBP);
  u16* KCMP = (u16*)(p.ws + OFF_KCMP);
  u16* VCMPT = (u16*)(p.ws + OFF_VCMPT);
  {
    if (it2 < 4) {
      const int b = bsel, hh = it2;
      const float fb = p.in[2][l * 4 + hh];
      double* part = (double*)smem;
      double loc[8];
      double run = 0.0;
#pragma unroll
      for (int j = 0; j < 8; ++j) {
        const int t = tid * 8 + j;
        const float f = MISC[(size_t)(b * T_ + t) * 32 + hh] + fb;
        const float ls = fminf(f, 0.f) - log1pf(__expf(-fabsf(f)));
        run += (double)ls;
        loc[j] = run;
      }
      double incl = run;
#pragma unroll
      for (int o = 1; o < 64; o <<= 1) {
        const double t2 = __shfl_up(incl, o);
        if (lane >= o) incl += t2;
      }
      if (lane == 63) part[wid] = incl;
      __syncthreads();
      double base = incl - run;
      for (int w = 0; w < wid; ++w) base += part[w];
#pragma unroll
      for (int j = 0; j < 8; ++j) CL[(size_t)(b * 4 + hh) * T_ + tid * 8 + j] = (float)(-(base + loc[j]) * (double)LOG2E);
      __syncthreads();
      return;
    }
    const int it = it2 - 4;
    const int ch = it & 3, kv = (it >> 2) & 1, g = (it >> 3) & 1, b = bsel;
    const u16* A = CH + (size_t)((kv ? CH_NSAVC : CH_NSAKC) + g) * CHSZ + (size_t)b * T_ * 64;
    int c = ch * 32 + (lane & 31);
    c = c > 126 ? 126 : c;
    const float* cbp = CBP + (size_t)(l * 2 + kv) * 8 * 128;
    float* HID = (float*)smem;
    const float* w2 = p.in[kv ? 8 : 5] + (size_t)l * 128 * 64;
    const float* W2S = (const float*)(smem + 32768);
#pragma unroll
    for (int i = 0; i < 8; ++i) glds16(w2 + (tid + 256 * i) * 4, smem + 32768 + (tid + 256 * i) * 16);
    gemm32x128_ksplit(A + (size_t)c * 1024, WC1 + (size_t)(l * 2 + kv) * 128 * 2048, 2048, 2048, HID, wid, lane);
    {
      const int col = tid & 127;
      float bsum = 0.f;
#pragma unroll
      for (int q = 0; q < 8; ++q) bsum += cbp[q * 128 + col];
#pragma unroll
      for (int i = 0; i < 16; ++i) {
        float* hp = HID + ((tid >> 7) + 2 * i) * 129 + col;
        *hp = gelu_tanh(*hp + bsum);
      }
    }
    wait_vm0();
    __syncthreads();
    {
      const int d = tid & 63, rq = tid >> 6;
      float o[8];
#pragma unroll
      for (int r = 0; r < 8; ++r) o[r] = 0.f;
#pragma unroll 4
      for (int k = 0; k < 128; ++k) {
        const float wv = W2S[k * 64 + d];
#pragma unroll
        for (int r = 0; r < 8; ++r) o[r] += HID[(rq + 4 * r) * 129 + k] * wv;
      }
#pragma unroll
      for (int r = 0; r < 8; ++r) {
        const int cc = ch * 32 + rq + 4 * r;
        const float v = (cc < 127) ? o[r] : 0.f;
        if (!kv) KCMP[((size_t)(b * 2 + g) * 128 + cc) * 64 + d] = f2bf(v);
        else VCMPT[((size_t)(b * 2 + g) * 64 + d) * 128 + cc] = f2bf(v);
      }
    }
    __syncthreads();
  }
}

DEVI void load_qfrag(const u16* Qrow  , int lane, bf8 (&qf)[4]) {
  const int h = lane >> 5;
#pragma unroll
  for (int s = 0; s < 4; ++s) qf[s] = *(const bf8*)(Qrow + 16 * s + 8 * h);
}

DEVI void load_tile64(const u16* src, long ld, char* lds) {
  const int tid = get_tid();
#pragma unroll
  for (int i = 0; i < 2; ++i) {
    const int pslot = tid + 256 * i, row = pslot >> 3, cp = pslot & 7;
    const int c = cp ^ ((row >> 1) & 7);
    glds16(src + (long)row * ld + c * 8, lds + tid * 16 + i * 4096);
  }
}

enum { M_FOX = 0, M_WIN = 1, M_SLC = 2, M_DSA = 3 };

template <int MODE>
DEVI void flash_block(const bf8 (&qf)[4], const u16* K, const u16* Vt, int q0, int kt0, int kt1, const float* bias,
                      unsigned selm, unsigned umask, const u64* dmrow, char* smem, f32x16 (&O)[2]) {
  const int tid = get_tid(), lane = tid & 63, wid = tid >> 6, h = lane >> 5;
  const int qw0 = q0 + 32 * wid, q = qw0 + (lane & 31);
  O[0] = (f32x16){0.f}; O[1] = (f32x16){0.f};
#pragma unroll
  for (int r = 0; r < 16; ++r) { O[0][r] = 0.f; O[1][r] = 0.f; }
  float mrun = -1e30f, lrun = 0.f;
  const int swk = ((lane & 31) >> 1) & 7;
  u64 um64 = ~0ull;
  if (MODE == M_SLC) um64 = (u64)umask;
  um64 &= (kt1 >= 64 ? ~0ull : ((1ull << kt1) - 1ull)) & (~0ull << kt0);
  auto issue = [&](int kt, int buf) {
    char* base = smem + buf * 16896;
    const int k0 = kt * 64;
    load_tile64(K + (long)k0 * 64, 64, base);
    load_tile64(Vt + k0, T_, base + 8192);
    if (MODE == M_FOX) { if (tid < 16) glds16(bias + k0 + tid * 4, base + 16384 + tid * 16); }
  };
  __syncthreads();
  int kt = um64 ? (int)__builtin_ctzll(um64) : 64;
  u64 dm_pref = 0;
  if (MODE == M_DSA) { if (kt < 64) dm_pref = dmrow[kt]; }
  if (kt < 64) issue(kt, 0);
  int cur = 0;
  while (kt < 64) {
    const u64 rem = (kt >= 63) ? 0ull : (um64 & (~0ull << (kt + 1)));
    const int nxt = rem ? (int)__builtin_ctzll(rem) : 64;
    wait_vm0();
    __syncthreads();
    u64 dm_next = 0;
    if (MODE == M_DSA) { dm_next = dm_pref; if (nxt < 64) dm_pref = dmrow[nxt]; }
    if (nxt < 64) issue(nxt, cur ^ 1);
    const char* SK = smem + cur * 16896;
    const char* SV = SK + 8192;
    const float* SBias = (const float*)(SK + 16384);
    const int k0 = kt * 64;
    bool active = true;
    if (MODE != M_DSA) active = (k0 <= qw0 + 31);
    if (MODE == M_WIN) active = active && (k0 + 63 >= qw0 - 511);
    u64 dm = 0;
    if (MODE == M_DSA) { dm = dm_next; }
    if (active) {
      f32x16 S[2];
#pragma unroll
      for (int tk = 0; tk < 2; ++tk) {
        if (MODE == M_FOX) {
#pragma unroll
          for (int g4 = 0; g4 < 4; ++g4) {
            const f32x4 bv = *(const f32x4*)(SBias + 32 * tk + 8 * g4 + 4 * h);
#pragma unroll
            for (int e = 0; e < 4; ++e) S[tk][4 * g4 + e] = bv[e];
          }
        } else if (MODE == M_SLC) {
          const float iv = ((selm >> kt) & 1u) ? 0.f : -INFINITY;
#pragma unroll
          for (int r = 0; r < 16; ++r) S[tk][r] = iv;
        } else if (MODE == M_DSA) {
          const unsigned w4 = (tk ? (unsigned)(dm >> 32) : (unsigned)dm) >> (4 * h);
#pragma unroll
          for (int g4 = 0; g4 < 4; ++g4)
#pragma unroll
            for (int e = 0; e < 4; ++e)
              S[tk][4 * g4 + e] = __uint_as_float(~(unsigned)__builtin_amdgcn_sbfe((int)w4, 8 * g4 + e, 1) & 0xff800000u);
        } else {
#pragma unroll
          for (int r = 0; r < 16; ++r) S[tk][r] = 0.f;
        }
        __builtin_amdgcn_s_setprio(1);
#pragma unroll
        for (int s = 0; s < 4; ++s) {
          const bf8 kf = *(const bf8*)(SK + (32 * tk + (lane & 31)) * 128 + (((2 * s + h) ^ swk) << 4));
          S[tk] = __builtin_amdgcn_mfma_f32_32x32x16_bf16(kf, qf[s], S[tk], 0, 0, 0);
        }
        __builtin_amdgcn_s_setprio(0);
      }
      const bool diag = (MODE != M_DSA) && (k0 + 63 > qw0);
      const bool lowb = (MODE == M_WIN) && (k0 < qw0 + 31 - 511);
      if (diag || lowb) {
#pragma unroll
        for (int tk = 0; tk < 2; ++tk)
#pragma unroll
          for (int r = 0; r < 16; ++r) {
            const int key = k0 + 32 * tk + 8 * (r >> 2) + 4 * h + (r & 3);
            bool valid = key <= q;
            if (MODE == M_WIN) valid = valid && (key > q - 512);
            S[tk][r] = valid ? S[tk][r] : -INFINITY;
          }
      }
      float mx = fmaxf(S[0][0], S[1][0]);
#pragma unroll
      for (int r = 1; r < 16; ++r) mx = fmaxf(mx, fmaxf(S[0][r], S[1][r]));
      mx = xhalf_max(mx);
      const float mnew = fmaxf(mrun, mx);
      const float alpha = fexp2(mrun - mnew);
      const bool grew = mnew > mrun;
      mrun = mnew;
      float ps = 0.f;
      bf8 pf[2][2];
#pragma unroll
      for (int tk = 0; tk < 2; ++tk)
#pragma unroll
        for (int r = 0; r < 16; ++r) {
          const float pv = fexp2(S[tk][r] - mnew);
          ps += pv;
          pf[tk][r >> 3][r & 7] = (__bf16)pv;
        }
      lrun = lrun * alpha + ps;
      if (__any(grew)) {
#pragma unroll
        for (int r = 0; r < 16; ++r) { O[0][r] *= alpha; O[1][r] *= alpha; }
      }
      __builtin_amdgcn_sched_barrier(0);
      __builtin_amdgcn_s_setprio(1);
#pragma unroll
      for (int dt = 0; dt < 2; ++dt) {
        const int d = 32 * dt + (lane & 31);
        const char* vrow = SV + d * 128;
        const int swv = (d >> 1) & 7;
#pragma unroll
        for (int tk = 0; tk < 2; ++tk)
#pragma unroll
          for (int s = 0; s < 2; ++s) {
            const int c1 = 4 * tk + 2 * s;
            const bf4 lo = *(const bf4*)(vrow + ((c1 ^ swv) << 4) + 8 * h);
            const bf4 hi = *(const bf4*)(vrow + (((c1 + 1) ^ swv) << 4) + 8 * h);
            bf8 vf;
            vf[0] = lo[0]; vf[1] = lo[1]; vf[2] = lo[2]; vf[3] = lo[3];
            vf[4] = hi[0]; vf[5] = hi[1]; vf[6] = hi[2]; vf[7] = hi[3];
            O[dt] = __builtin_amdgcn_mfma_f32_32x32x16_bf16(vf, pf[tk][s], O[dt], 0, 0, 0);
          }
      }
      __builtin_amdgcn_s_setprio(0);
    }
    kt = nxt;
    cur ^= 1;
  }
  const float lt = xhalf_sum(lrun);
  const float inv = lt > 0.f ? 1.f / lt : 0.f;
#pragma unroll
  for (int r = 0; r < 16; ++r) { O[0][r] *= inv; O[1][r] *= inv; }
}

DEVI void store_row8(const unsigned (&w)[2][4], u8* orow, int lane) {
  const int h = lane >> 5;
#pragma unroll
  for (int dt = 0; dt < 2; ++dt)
#pragma unroll
    for (int gp = 0; gp < 2; ++gp) {
      const auto r = __builtin_amdgcn_permlane32_swap(w[dt][2 * gp], w[dt][2 * gp + 1], false, false);
      *(uint2*)(orow + 32 * dt + 16 * gp + 8 * h) = make_uint2(r[0], r[1]);
    }
}
DEVI void store_o(const f32x16 (&O)[2], u8* orow  , int lane) {
  unsigned w[2][4];
#pragma unroll
  for (int dt = 0; dt < 2; ++dt)
#pragma unroll
    for (int g4 = 0; g4 < 4; ++g4)
      w[dt][g4] = pk4_f8c(O[dt][4 * g4] * F8_SO, O[dt][4 * g4 + 1] * F8_SO, O[dt][4 * g4 + 2] * F8_SO, O[dt][4 * g4 + 3] * F8_SO);
  store_row8(w, orow, lane);
}

DEVI void item_fox(const Params& p, int b, int h, int qb, char* smem) {
  const int tid = get_tid(), lane = tid & 63, wid = tid >> 6;
  const u16* CH = (const u16*)(p.ws + OFF_CH);
  const u16* Q = CH + (size_t)(CH_FOXQ + h) * CHSZ + (size_t)b * T_ * 64;
  const u16* K = CH + (size_t)(CH_FOXK + h) * CHSZ + (size_t)b * T_ * 64;
  const u16* Vt = CH + (size_t)(CH_FOXV + h) * CHSZ + (size_t)b * 64 * T_;
  const float* bias = (const float*)(p.ws + OFF_CL) + (size_t)(b * 4 + h) * T_;
  const int q0 = qb * 128, q = q0 + 32 * wid + (lane & 31);
  bf8 qf[4];
  load_qfrag(Q + (size_t)q * 64, lane, qf);
  f32x16 O[2];
  flash_block<M_FOX>(qf, K, Vt, q0, 0, q0 / 64 + 2, bias, 0u, 0u, nullptr, smem, O);
  u8* o = (u8*)(p.ws + OFF_O) + (size_t)(b * T_ + q) * DM + h * 64;
  store_o(O, o, lane);
}

DEVI void item_cmp(const Params& p, int b, int g, int qb, char* smem) {
  const int tid = get_tid(), lane = tid & 63, wid = tid >> 6, h = lane >> 5;
  const int bg = b * 2 + g;
  const u16* CH = (const u16*)(p.ws + OFF_CH);
  const u16* KC = (const u16*)(p.ws + OFF_KCMP) + (size_t)bg * 128 * 64;
  const u16* VCT = (const u16*)(p.ws + OFF_VCMPT) + (size_t)bg * 64 * 128;
  const float* MISC = (const float*)(p.ws + OFF_MISC);
  float* OCMP = (float*)(p.ws + OFF_OCMP);
  unsigned* SELM = (unsigned*)(p.ws + OFF_SELM);
  char* SK = smem;
  char* SV = smem + 16384;
  load_tile64(KC, 64, SK);
  load_tile64(KC + 64 * 64, 64, SK + 8192);
#pragma unroll
  for (int j = 0; j < 4; ++j) {
    const int pslot = tid + 256 * j, row = pslot >> 4, cp = pslot & 15;
    const int c = cp ^ ((row >> 1) & 7);
    glds16(VCT + (size_t)row * 128 + c * 8, SV + tid * 16 + j * 4096);
  }
  wait_vm0();
  __syncthreads();
  const int q0 = qb * 128, qw0 = q0 + 32 * wid, t = qw0 + (lane & 31);
  const int tok = b * T_ + t;
  const int swk = ((lane & 31) >> 1) & 7;
  float* GLg = (float*)(smem + 32768) + wid * 2112 + (lane & 31) * 33;
  float* GLl = GLg + 1056;
#pragma unroll
  for (int j = 0; j < 16; ++j) { GLg[2 * j + h] = 0.f; GLl[2 * j + h] = 0.f; }
  int nvis = t >= 31 ? ((t - 31) >> 4) + 1 : 0;
  nvis = nvis > 127 ? 127 : nvis;
#pragma unroll 1
  for (int r3 = 0; r3 < 3; ++r3) {
    const int head = g * 3 + r3;
    bf8 qf[4];
    load_qfrag(CH + (size_t)(CH_NSAQ + head) * CHSZ + (size_t)tok * 64, lane, qf);
    int nv = nvis;
    asm volatile("" : "+v"(nv));
    float mrun = -1e30f, lrun = 0.f;
#pragma unroll 1
    for (int tk = 0; tk < 4; ++tk) {
      f32x16 S;
#pragma unroll
      for (int r = 0; r < 16; ++r) S[r] = 0.f;
#pragma unroll
      for (int s = 0; s < 4; ++s) {
        const bf8 kf = *(const bf8*)(SK + (32 * tk + (lane & 31)) * 128 + (((2 * s + h) ^ swk) << 4));
        S = __builtin_amdgcn_mfma_f32_32x32x16_bf16(kf, qf[s], S, 0, 0, 0);
      }
      float mx = -INFINITY;
#pragma unroll
      for (int r = 0; r < 16; ++r) {
        const int c = 32 * tk + 8 * (r >> 2) + 4 * h + (r & 3);
        const bool valid = c < nv;
        const float sv = valid ? S[r] : -INFINITY;
        S[r] = sv;
        mx = fmaxf(mx, sv);
      }
      mx = xhalf_max(mx);
      const float mnew = fmaxf(mrun, mx);
      float ps = 0.f;
#pragma unroll
      for (int r = 0; r < 16; ++r) ps += fexp2(S[r] - mnew);
      lrun = lrun * fexp2(mrun - mnew) + ps;
      mrun = mnew;
    }
    const float lt = xhalf_sum(lrun);
    const float inv = lt > 0.f ? 1.f / lt : 0.f;
    asm volatile("" : "+v"(nv));
    f32x16 O[2];
#pragma unroll
    for (int r = 0; r < 16; ++r) { O[0][r] = 0.f; O[1][r] = 0.f; }
#pragma unroll
    for (int tk = 0; tk < 4; ++tk) {
      f32x16 S;
#pragma unroll
      for (int r = 0; r < 16; ++r) S[r] = 0.f;
#pragma unroll
      for (int s = 0; s < 4; ++s) {
        const bf8 kf = *(const bf8*)(SK + (32 * tk + (lane & 31)) * 128 + (((2 * s + h) ^ swk) << 4));
        S = __builtin_amdgcn_mfma_f32_32x32x16_bf16(kf, qf[s], S, 0, 0, 0);
      }
      bf8 pf[2];
#pragma unroll
      for (int r = 0; r < 16; ++r) {
        const int c = 32 * tk + 8 * (r >> 2) + 4 * h + (r & 3);
        const bool valid = c < nv;
        const float pv = valid ? fexp2(S[r] - mrun) * inv : 0.f;
        S[r] = pv;
        pf[r >> 3][r & 7] = (__bf16)pv;
      }
#pragma unroll
      for (int g4 = 0; g4 < 4; ++g4) {
        const int j = 2 * (4 * tk + g4) + h;
        GLg[j] += (S[4 * g4] + S[4 * g4 + 1]) + (S[4 * g4 + 2] + S[4 * g4 + 3]);
        GLl[j] += S[4 * g4 + 3];
      }
#pragma unroll
      for (int dt = 0; dt < 2; ++dt) {
        const int d = 32 * dt + (lane & 31);
        const char* vrow = SV + d * 256;
        const int swv = (d >> 1) & 7;
#pragma unroll
        for (int s = 0; s < 2; ++s) {
          const int c1 = 4 * tk + 2 * s;
          const bf4 lo = *(const bf4*)(vrow + ((c1 ^ swv) << 4) + 8 * h);
          const bf4 hi = *(const bf4*)(vrow + (((c1 + 1) ^ swv) << 4) + 8 * h);
          bf8 vf;
          vf[0] = lo[0]; vf[1] = lo[1]; vf[2] = lo[2]; vf[3] = lo[3];
          vf[4] = hi[0]; vf[5] = hi[1]; vf[6] = hi[2]; vf[7] = hi[3];
          O[dt] = __builtin_amdgcn_mfma_f32_32x32x16_bf16(vf, pf[s], O[dt], 0, 0, 0);
        }
      }
      __builtin_amdgcn_sched_barrier(0);
    }
    const float gate = sigmoidf_(MISC[(size_t)tok * 32 + 4 + head]);
    float* oc = OCMP + (size_t)tok * 384 + head * 64;
#pragma unroll
    for (int dt = 0; dt < 2; ++dt)
#pragma unroll
      for (int g4 = 0; g4 < 4; ++g4) {
        f32x4 v = (f32x4){O[dt][4 * g4] * gate, O[dt][4 * g4 + 1] * gate, O[dt][4 * g4 + 2] * gate, O[dt][4 * g4 + 3] * gate};
        *(f32x4*)(oc + 32 * dt + 8 * g4 + 4 * h) = v;
      }
  }
  {
    const int blk_t = t >> 6;
    float w[32];
#pragma unroll
    for (int k = 0; k < 32; ++k) {
      const int j = (k + h) & 31;
      float x = GLg[j] + (j > 0 ? GLl[j > 0 ? j - 1 : 0] : 0.f);
      const bool forced = (j == 0) || (j == blk_t) || (j == blk_t - 1);
      x = (j <= blk_t) ? (forced ? 1e6f : x) : -1.f;
      w[k] = x;
    }
    unsigned mask = 0;
#pragma unroll
    for (int jj = 0; jj < 16; ++jj) {
      const int k0 = 2 * jj;
      const float vj = w[k0];
      int rank = 0;
#pragma unroll
      for (int k = 0; k < 32; ++k) {
        const bool lower = (k < k0) || (k == 31 && h);
        rank += (w[k] > vj) || (w[k] == vj && lower);
      }
      if (rank < 16) mask |= 1u << (k0 + h);
    }
    mask = xhalf_or(mask);
    if (h == 0) SELM[(size_t)bg * T_ + t] = mask;
  }
  __syncthreads();
}

template <int NJ>
DEVI void idx_select(const float* scr, u64* DMASK, int b, int q0, int wid, int lane) {
  auto load_keys = [&](int rr, float (&raw)[NJ]) {
    if (q0 + rr >= 256) {
      const float* src = scr + (size_t)rr * 2048 + lane;
#pragma unroll
      for (int j = 0; j < NJ; ++j) raw[j] = __builtin_nontemporal_load(src + 64 * j);
    }
  };
  auto select_row = [&](int rr, const float (&raw)[NJ]) {
    const int tr = q0 + rr;
    u64* drow = DMASK + (size_t)(b * T_ + tr) * 32;
    if (tr < 256) {
      if (lane < 32) {
        const int lo = lane * 64;
        drow[lane] = (tr >= lo + 63) ? ~0ull : (tr < lo ? 0ull : ((2ull << (tr - lo)) - 1ull));
      }
      return;
    }
    unsigned key[NJ];
#pragma unroll
    for (int j = 0; j < NJ; ++j) {
      const unsigned bits = __float_as_uint(raw[j]);
      const unsigned kk = (bits & 0x80000000u) ? ~bits : (bits | 0x80000000u);
      key[j] = (lane + 64 * j <= tr) ? kk : 0u;
    }
    unsigned prefix = 0u;
    for (int bit = 31; bit >= 0; --bit) {
      const unsigned cand = prefix | (1u << bit);
      int cl = 0;
#pragma unroll
      for (int j = 0; j < NJ; ++j) cl += (key[j] >= cand) ? 1 : 0;
      int c = 0;
#pragma unroll
      for (int sb = 0; sb < 6; ++sb) c += __popcll(__ballot((cl >> sb) & 1)) << sb;
      if (c >= 256) prefix = cand;
      if (c == 256) break;
    }
    int cgl = 0;
#pragma unroll
    for (int j = 0; j < NJ; ++j) cgl += (key[j] > prefix) ? 1 : 0;
    int cgt = 0;
#pragma unroll
    for (int sb = 0; sb < 6; ++sb) cgt += __popcll(__ballot((cgl >> sb) & 1)) << sb;
    int need = 256 - cgt;
    const u64 lt_mask = (1ull << lane) - 1ull;
#pragma unroll
    for (int j = 0; j < NJ; ++j) {
      const u64 eqm = __ballot(key[j] == prefix);
      const int myrank = __popcll(eqm & lt_mask);
      const bool sel = (key[j] > prefix) || (key[j] == prefix && myrank < need);
      need -= __popcll(eqm);
      const u64 word = __ballot(sel);
      if (lane == 0) drow[j] = word;
    }
    if (NJ < 32) { if (lane >= NJ && lane < 32) drow[lane] = 0ull; }
  };
  float ka[NJ], kb[NJ];
  load_keys(wid * 8, ka);
#pragma unroll 1
  for (int r2 = 0; r2 < 4; ++r2) {
    const int rr = wid * 8 + 2 * r2;
    load_keys(rr + 1, kb);
    select_row(rr, ka);
    if (r2 < 3) load_keys(rr + 2, ka);
    select_row(rr + 1, kb);
  }
}

DEVI void item_idx(const Params& p, int b, int qb, char* smem, int pflags) {
  const int tid = get_tid(), lane = tid & 63, wid = tid >> 6, h = lane >> 5;
  const u16* CH = (const u16*)(p.ws + OFF_CH);
  const u16* KI = CH + (size_t)CH_IDXK * CHSZ + (size_t)b * T_ * 64;
  const float* MISC = (const float*)(p.ws + OFF_MISC);
  float* scr = (float*)(p.ws + OFF_DSCR) + (size_t)blockIdx.x * 32 * 2048;
  u64* DMASK = (u64*)(p.ws + ((pflags & 16) ? WS_NEED : OFF_DMASK));
  const int q0 = qb * 32, t = q0 + (lane & 31), tok = b * T_ + t;
  const int nkt = q0 / 64 + 1;
  if (!(pflags & 16)) {
    bf8 qf[4][4];
    float w[4];
#pragma unroll
    for (int hd = 0; hd < 4; ++hd) {
      load_qfrag(CH + (size_t)(CH_IDXQ + hd) * CHSZ + (size_t)tok * 64, lane, qf[hd]);
      w[hd] = MISC[(size_t)tok * 32 + 22 + hd];
    }
    bf8 kfA[4], kfB[4];
#define IDX_LOADK(KF, KT, TK)                                                                     \
  {                                                                                               \
    const u16* krow = KI + (size_t)((KT) * 64 + 32 * (TK) + (lane & 31)) * 64;                     \
    _Pragma("unroll") for (int s = 0; s < 4; ++s) KF[s] = *(const bf8*)(krow + 16 * s + 8 * h);    \
  }
#define IDX_SCORE(KF, KT, TK)                                                                     \
  {                                                                                               \
    f32x16 sc;                                                                                    \
    _Pragma("unroll") for (int r = 0; r < 16; ++r) sc[r] = 0.f;                                    \
    _Pragma("unroll") for (int hd = 0; hd < 4; ++hd) {                                             \
      f32x16 S;                                                                                   \
      _Pragma("unroll") for (int r = 0; r < 16; ++r) S[r] = 0.f;                                   \
      _Pragma("unroll") for (int s = 0; s < 4; ++s) S = __builtin_amdgcn_mfma_f32_32x32x16_bf16(KF[s], qf[hd][s], S, 0, 0, 0); \
      _Pragma("unroll") for (int r = 0; r < 16; ++r) sc[r] += w[hd] * fmaxf(S[r], 0.f);            \
    }                                                                                             \
    float* dst = scr + (size_t)(lane & 31) * 2048 + (KT) * 64 + 32 * (TK) + 4 * h;                 \
    _Pragma("unroll") for (int g4 = 0; g4 < 4; ++g4)                                               \
      *(f32x4*)(dst + 8 * g4) = (f32x4){sc[4 * g4] + 0.f, sc[4 * g4 + 1] + 0.f, sc[4 * g4 + 2] + 0.f, sc[4 * g4 + 3] + 0.f}; \
  }
    int kt = wid;
    if (kt < nkt) IDX_LOADK(kfA, kt, 0)
#pragma unroll 1
    for (; kt < nkt; kt += 4) {
      IDX_LOADK(kfB, kt, 1)
      IDX_SCORE(kfA, kt, 0)
      if (kt + 4 < nkt) IDX_LOADK(kfA, kt + 4, 0)
      IDX_SCORE(kfB, kt, 1)
    }
#undef IDX_LOADK
#undef IDX_SCORE
  }
  wait_vm0();
  __syncthreads();
  if (!(pflags & 8)) {
    const int njr = (nkt + 7) >> 3;
    if (njr <= 1) idx_select<8>(scr, DMASK, b, q0, wid, lane);
    else if (njr == 2) idx_select<16>(scr, DMASK, b, q0, wid, lane);
    else if (njr == 3) idx_select<24>(scr, DMASK, b, q0, wid, lane);
    else idx_select<32>(scr, DMASK, b, q0, wid, lane);
  }
  __syncthreads();
}

DEVI void item_nsa(const Params& p, int b, int head, int qb, char* smem) {
  const int tid = get_tid(), lane = tid & 63, wid = tid >> 6, h = lane >> 5;
  const int g = head / 3;
  const u16* CH = (const u16*)(p.ws + OFF_CH);
  const float* MISC = (const float*)(p.ws + OFF_MISC);
  const int q0 = qb * 128, q = q0 + 32 * wid + (lane & 31), tok = b * T_ + q;
  bf8 qf[4];
  load_qfrag(CH + (size_t)(CH_NSAQ + head) * CHSZ + (size_t)tok * 64, lane, qf);
  const unsigned selm = ((const unsigned*)(p.ws + OFF_SELM))[(size_t)(b * 2 + g) * T_ + q];
  unsigned um = selm;
#pragma unroll
  for (int o = 32; o > 0; o >>= 1) um |= __shfl_xor(um, o);
  unsigned* red = (unsigned*)(smem + 40960);
  if (lane == 0) red[wid] = um;
  __syncthreads();
  um = red[0] | red[1] | red[2] | red[3];
  __syncthreads();
  f32x16 O1[2], O2[2];
  flash_block<M_SLC>(qf, CH + (size_t)(CH_NSAKS + g) * CHSZ + (size_t)b * T_ * 64,
                     CH + (size_t)(CH_NSAVS + g) * CHSZ + (size_t)b * 64 * T_, q0, 0, q0 / 64 + 2, nullptr, selm, um, nullptr, smem, O1);
  int kt0 = (q0 - 511) >> 6;
  kt0 = kt0 < 0 ? 0 : kt0;
  flash_block<M_WIN>(qf, CH + (size_t)(CH_NSAKW + g) * CHSZ + (size_t)b * T_ * 64,
                     CH + (size_t)(CH_NSAVW + g) * CHSZ + (size_t)b * 64 * T_, q0, kt0, q0 / 64 + 2, nullptr, 0u, 0u, nullptr, smem, O2);
  const float g1 = sigmoidf_(MISC[(size_t)tok * 32 + 4 + 6 + head]);
  const float g2 = sigmoidf_(MISC[(size_t)tok * 32 + 4 + 12 + head]);
  const float* oc = (const float*)(p.ws + OFF_OCMP) + (size_t)tok * 384 + head * 64;
  u8* o = (u8*)(p.ws + OFF_O) + (size_t)tok * DM + 256 + head * 64;
  unsigned ow[2][4];
#pragma unroll
  for (int dt = 0; dt < 2; ++dt)
#pragma unroll
    for (int g4 = 0; g4 < 4; ++g4) {
      const int d = 32 * dt + 8 * g4 + 4 * h;
      const f32x4 c = *(const f32x4*)(oc + d);
      float v[4];
#pragma unroll
      for (int e = 0; e < 4; ++e) v[e] = c[e] + g1 * O1[dt][4 * g4 + e] + g2 * O2[dt][4 * g4 + e];
      ow[dt][g4] = pk4_f8c(v[0] * F8_SO, v[1] * F8_SO, v[2] * F8_SO, v[3] * F8_SO);
    }
  store_row8(ow, o, lane);
}

DEVI void item_dsa(const Params& p, int b, int head, int qb, char* smem) {
  const int tid = get_tid(), lane = tid & 63, wid = tid >> 6;
  const u16* CH = (const u16*)(p.ws + OFF_CH);
  const int q0 = qb * 128, q = q0 + 32 * wid + (lane & 31), tok = b * T_ + q;
  bf8 qf[4];
  load_qfrag(CH + (size_t)(CH_DSAQ + head) * CHSZ + (size_t)tok * 64, lane, qf);
  const u64* dmrow = (const u64*)(p.ws + OFF_DMASK) + (size_t)tok * 32;
  f32x16 O[2];
  flash_block<M_DSA>(qf, CH + (size_t)CH_DSAK * CHSZ + (size_t)b * T_ * 64, CH + (size_t)CH_DSAV * CHSZ + (size_t)b * 64 * T_, q0, 0,
                     q0 / 64 + 2, nullptr, 0u, 0u, dmrow, smem, O);
  u8* o = (u8*)(p.ws + OFF_O) + (size_t)tok * DM + 640 + head * 64;
  store_o(O, o, lane);
}

DEVI void phase_attn(const Params& p, int l, char* smem) {
  const int b = blockIdx.x & 7;
  unsigned* bar = (unsigned*)(p.ws + OFF_BAR);
  unsigned* ctr = bar + XB_WCTR + (l * 2) * 8 + b;
  unsigned* s2done = bar + XB_WCTR + 320 + l * 8 + b;
  unsigned* idxdone = bar + XB_WCTR + 448 + l * 8 + b;
  unsigned* cmpdone = bar + XB_WCTR + 480 + l * 8 + b;
  bool s2ready = false, idxready = false, cmpready = false;
  auto publish = [&](unsigned* cnt) {
    wait_vm0();
    __syncthreads();
    if (threadIdx.x == 0) {
      __builtin_amdgcn_fence(__ATOMIC_RELEASE, "agent");
      asm volatile("s_waitcnt vmcnt(0)" ::: "memory");
      (void)xb_add(cnt, 1u);
    }
  };
  auto await = [&](unsigned* cnt, unsigned need) {
    if (threadIdx.x == 0) {
      XB_SPIN(xb_ld(cnt) < need, bar);
      __builtin_amdgcn_fence(__ATOMIC_ACQUIRE, "agent");
      asm volatile("s_waitcnt vmcnt(0)" ::: "memory");
    }
    __syncthreads();
  };
  const int nbq = gridDim.x >> 3, bq = blockIdx.x >> 3;
  for (int it = bq < nbq ? bq : nbq + next_item(ctr, smem); it < 372; it = nbq + next_item(ctr, smem)) {
    if (it < 20) {
      item_s2(p, l, b, it, smem);
      publish(s2done);
      continue;
    }
    const int i2 = it - 20;
    if (i2 < 64) {
      item_idx(p, b, 63 - i2, smem, 0);
      publish(idxdone);
      continue;
    }
    if (i2 < 160 && !s2ready) { await(s2done, 20u); s2ready = true; }
    if (i2 < 96) {
      item_cmp(p, b, (i2 - 64) >> 4, (i2 - 64) & 15, smem);
      publish(cmpdone);
    } else if (i2 < 160) {
      item_fox(p, b, (i2 - 96) & 3, 15 - ((i2 - 96) >> 2), smem);
    } else if (i2 < 256) {
      if (!idxready) { await(idxdone, 64u); idxready = true; }
      const int j = i2 - 160;
      item_dsa(p, b, j % 6, 15 - j / 6, smem);
    } else {
      if (!cmpready) { await(cmpdone, 32u); cmpready = true; }
      const int j = i2 - 256;
      item_nsa(p, b, j % 6, 15 - j / 6, smem);
    }
  }
}

DEVI void phase_outproj(const Params& p, int l, char* smem) {
  const int tid = get_tid(), lane = tid & 63, wid = tid >> 6, wr = wid >> 1, wc = wid & 1;
  const u8* O = (const u8*)(p.ws + OFF_O);
  const u8* WO = (const u8*)(p.ws + OFF_WO) + (size_t)l * DM * DM;
  const float* x0 = p.in[0];
  u16* h1 = (u16*)(p.ws + OFF_XBUF);
  XCD_LOOP(it, 128 * 8) {
    const int mt = it >> 3, nt = it & 7;
    long aoff[4];
#pragma unroll
    for (int q = 0; q < 4; ++q) aoff[q] = (long)(mt * 128 + (tid >> 3) + 32 * q) * DM;
    f32x4 acc[4][4];
    gemm128_f8(O, aoff, WO, DM, nt * 128, DM, smem, acc);
#pragma unroll
    for (int m = 0; m < 4; ++m) {
      const size_t row = mt * 128 + wr * 64 + m * 16 + (lane & 15);
      const int col0 = nt * 128 + wc * 64 + 16 * (lane >> 4);
#pragma unroll
      for (int n2 = 0; n2 < 2; ++n2) {
        float xs[8];
        if (l == 0) {
          const f32x4 xa = *(const f32x4*)(x0 + row * DM + col0 + 8 * n2), xb = *(const f32x4*)(x0 + row * DM + col0 + 8 * n2 + 4);
#pragma unroll
          for (int q = 0; q < 4; ++q) { xs[q] = xa[q]; xs[4 + q] = xb[q]; }
        } else {
          const uint4 xv = *(const uint4*)(h1 + row * DM + col0 + 8 * n2);
          const unsigned w[4] = {xv.x, xv.y, xv.z, xv.w};
#pragma unroll
          for (int q = 0; q < 4; ++q) { xs[2 * q] = __uint_as_float(w[q] << 16); xs[2 * q + 1] = __uint_as_float(w[q] & 0xffff0000u); }
        }
        float v[8];
#pragma unroll
        for (int q = 0; q < 4; ++q) {
          v[q] = ALPHA * xs[q] + acc[m][2 * n2][q] * (1.f / (F8_SW * F8_SO));
          v[4 + q] = ALPHA * xs[4 + q] + acc[m][2 * n2 + 1][q] * (1.f / (F8_SW * F8_SO));
        }
        *(uint4*)(h1 + row * DM + col0 + 8 * n2) = make_uint4(pk2(v[0], v[1]), pk2(v[2], v[3]), pk2(v[4], v[5]), pk2(v[6], v[7]));
      }
    }
  }
}

DEVI void ln_row(float (&v)[16], const float* g, const float* bta, int lane) {
  float s = 0.f;
#pragma unroll
  for (int j = 0; j < 16; ++j) s += v[j];
  const float mu = wave_sum(s) * (1.f / DM);
  float s2 = 0.f;
#pragma unroll
  for (int j = 0; j < 16; ++j) { const float d = v[j] - mu; s2 += d * d; }
  const float rstd = rsqrtf(wave_sum(s2) * (1.f / DM) + LN_EPS);
#pragma unroll
  for (int i = 0; i < 4; ++i) {
    const int c = lane * 4 + 256 * i;
    const float4 gg = *(const float4*)(g + c), bb = *(const float4*)(bta + c);
    v[4 * i + 0] = (v[4 * i + 0] - mu) * rstd * gg.x + bb.x;
    v[4 * i + 1] = (v[4 * i + 1] - mu) * rstd * gg.y + bb.y;
    v[4 * i + 2] = (v[4 * i + 2] - mu) * rstd * gg.z + bb.z;
    v[4 * i + 3] = (v[4 * i + 3] - mu) * rstd * gg.w + bb.w;
  }
}

DEVI void ln_row8(float (&v)[16], const float* g, const float* bta, int lane) {
  float s = 0.f;
#pragma unroll
  for (int j = 0; j < 16; ++j) s += v[j];
  const float mu = wave_sum(s) * (1.f / DM);
  float s2 = 0.f;
#pragma unroll
  for (int j = 0; j < 16; ++j) { const float d = v[j] - mu; s2 += d * d; }
  const float rstd = rsqrtf(wave_sum(s2) * (1.f / DM) + LN_EPS);
#pragma unroll
  for (int i = 0; i < 2; ++i) {
    const int c = lane * 8 + 512 * i;
#pragma unroll
    for (int h = 0; h < 2; ++h) {
      const float4 gg = *(const float4*)(g + c + 4 * h), bb = *(const float4*)(bta + c + 4 * h);
      v[8 * i + 4 * h + 0] = (v[8 * i + 4 * h + 0] - mu) * rstd * gg.x + bb.x;
      v[8 * i + 4 * h + 1] = (v[8 * i + 4 * h + 1] - mu) * rstd * gg.y + bb.y;
      v[8 * i + 4 * h + 2] = (v[8 * i + 4 * h + 2] - mu) * rstd * gg.z + bb.z;
      v[8 * i + 4 * h + 3] = (v[8 * i + 4 * h + 3] - mu) * rstd * gg.w + bb.w;
    }
  }
}

DEVI void phase_ln1_router(const Params& p, int l, char* smem, int dup) {
  const int tid = get_tid(), lane = tid & 63, wid = tid >> 6, h = lane >> 5;
  const u16* h1 = (const u16*)(p.ws + OFF_XBUF);
  u8* X8 = (u8*)(p.ws + OFF_XA);
  u16* XB = (u16*)(p.ws + OFF_XB);
  u16* XL = (u16*)(p.ws + OFF_XL);
  const float* g1 = p.in[10] + l * DM;
  const float* b1 = p.in[11] + l * DM;
  const u16* WR2 = (const u16*)(p.ws + OFF_WR2) + (size_t)l * 128 * 2048;
  const float* BR = p.in[13] + l * NE;
  unsigned* CNT = (unsigned*)(p.ws + OFF_CNT) + l * 128 + 64 * dup;
  unsigned* LIST = (unsigned*)(p.ws + OFF_LIST);
  float* LISTW = (float*)(p.ws + OFF_LISTW);
  float* LG = (float*)smem;
  unsigned* lcnt = (unsigned*)(smem + 16640);
  unsigned* lbase = lcnt + 64;
  unsigned* pinfo = lcnt + 128;
  float* pgw = (float*)(pinfo + 256);
  XCD_LOOP(it, NTOK / 32) {
    {
      const size_t tok0 = (size_t)it * 32 + wid * 8;
      uint4 nx[2];
#pragma unroll
      for (int i = 0; i < 2; ++i) nx[i] = *(const uint4*)(h1 + tok0 * DM + lane * 8 + 512 * i);
#pragma unroll 1
      for (int tt = 0; tt < 8; ++tt) {
        const size_t tok = tok0 + tt;
        float v[16];
#pragma unroll
        for (int i = 0; i < 2; ++i) {
          const unsigned w[4] = {nx[i].x, nx[i].y, nx[i].z, nx[i].w};
#pragma unroll
          for (int q = 0; q < 4; ++q) { v[8 * i + 2 * q] = __uint_as_float(w[q] << 16); v[8 * i + 2 * q + 1] = __uint_as_float(w[q] & 0xffff0000u); }
        }
        if (tt < 7) {
#pragma unroll
          for (int i = 0; i < 2; ++i) nx[i] = *(const uint4*)(h1 + (tok + 1) * DM + lane * 8 + 512 * i);
        }
        ln_row8(v, g1, b1, lane);
#pragma unroll
        for (int i = 0; i < 2; ++i) {
          const int c = lane * 8 + 512 * i;
          uint4 hi, lo;
          hi.x = pk2(v[8 * i], v[8 * i + 1]); hi.y = pk2(v[8 * i + 2], v[8 * i + 3]);
          hi.z = pk2(v[8 * i + 4], v[8 * i + 5]); hi.w = pk2(v[8 * i + 6], v[8 * i + 7]);
          *(uint4*)(XB + tok * DM + c) = hi;
          *(uint2*)(X8 + tok * DM + c) = make_uint2(pk4_f8c(v[8 * i], v[8 * i + 1], v[8 * i + 2], v[8 * i + 3]),
                                                    pk4_f8c(v[8 * i + 4], v[8 * i + 5], v[8 * i + 6], v[8 * i + 7]));
          lo.x = pk2(v[8 * i] - __uint_as_float(hi.x << 16), v[8 * i + 1] - __uint_as_float(hi.x & 0xffff0000u));
          lo.y = pk2(v[8 * i + 2] - __uint_as_float(hi.y << 16), v[8 * i + 3] - __uint_as_float(hi.y & 0xffff0000u));
          lo.z = pk2(v[8 * i + 4] - __uint_as_float(hi.z << 16), v[8 * i + 5] - __uint_as_float(hi.z & 0xffff0000u));
          lo.w = pk2(v[8 * i + 6] - __uint_as_float(hi.w << 16), v[8 * i + 7] - __uint_as_float(hi.w & 0xffff0000u));
          *(uint4*)(XL + tok * DM + c) = lo;
        }
      }
    }
    if (tid < 64) lcnt[tid] = 0u;
    wait_vm0();
    __syncthreads();
    {
      const size_t trow = ((size_t)it * 32 + (lane & 31)) * DM;
      gemm32x128_ksplit_fm(XB + trow, XL + trow, WR2, LG, wid, lane);
    }
    const float br = BR[lane];
    const int lgc = (lane >> 5) * 64 + (lane & 31);
    for (int tt = 0; tt < 8; ++tt) {
      const int tl = wid * 8 + tt;
      const float s = sigmoidf_(LG[tl * 129 + lgc] + LG[tl * 129 + lgc + 32]);
      const float sb = s + br;
      const unsigned sbb = __float_as_uint(sb);
      unsigned gk = (sbb & 0x80000000u) ? ~sbb : (sbb | 0x80000000u);
      bool top2 = false;
#pragma unroll
      for (int k = 0; k < 2; ++k) {
        const unsigned gm = grp8_max_u(gk);
        const unsigned gb = (unsigned)(__ballot(gk == gm) >> (lane & ~7)) & 0xffu;
        if ((lane & 7) == (int)__builtin_ctz(gb)) { top2 = true; gk = 0u; }
      }
      const float gs = grp8_sum(top2 ? sb : 0.f);
      int grank = 0;
      const int myg = lane >> 3;
#pragma unroll
      for (int g = 0; g < 8; ++g) {
        const float og = __uint_as_float((unsigned)__builtin_amdgcn_readlane((int)__float_as_uint(gs), g * 8));
        grank += (og > gs) || (og == gs && g < myg);
      }
      const float vsel = grank < 4 ? sb : -1e30f;
      int rank = 64;
      {
        const unsigned vb = __float_as_uint(vsel);
        unsigned key = (vb & 0x80000000u) ? ~vb : (vb | 0x80000000u);
#pragma unroll
        for (int k = 0; k < 8; ++k) {
          const unsigned mx = wave_max_u(key);
          const int ln = (int)__builtin_ctzll(__ballot(key == mx));
          if (lane == ln) { rank = k; key = 0u; }
        }
      }
      const bool sel = rank < 8;
      const float ssum = wave_sum(sel ? s : 0.f);
      if (sel) {
        const unsigned ls = atomicAdd(&lcnt[lane], 1u);
        pinfo[tl * 8 + rank] = (unsigned)lane | (ls << 8);
        pgw[tl * 8 + rank] = s / ssum * 2.5f;
      }
    }
    __syncthreads();
    if (tid < 64) lbase[tid] = atomicAdd(&CNT[tid], lcnt[tid]);
    __syncthreads();
    {
      const unsigned inf = pinfo[tid];
      const unsigned e = inf & 255u, ls = inf >> 8;
      const unsigned pid = (unsigned)(it * 32) * 8u + (unsigned)tid;
      LIST[(size_t)e * NTOK + lbase[e] + ls] = pid;
      LISTW[(size_t)e * NTOK + lbase[e] + ls] = pgw[tid];
    }
    __syncthreads();
  }
}

DEVI void build_tiles(const unsigned* CNT, int* tb, int* rowb, int* cnts) {
  const int tid = get_tid();
  if (tid < 64) {
    const int c = (int)CNT[tid];
    const int nb = (c + 127) >> 7;
    int st = nb, sr = c;
#pragma unroll
    for (int o = 1; o < 64; o <<= 1) {
      const int t2 = __shfl_up(st, o), r2 = __shfl_up(sr, o);
      if (tid >= o) { st += t2; sr += r2; }
    }
    tb[tid] = st - nb; rowb[tid] = sr - c; cnts[tid] = c;
    if (tid == 63) { tb[64] = st; rowb[64] = sr; cnts[64] = NTOK; tb[65] = st + (NTOK >> 7); }
  }
  __syncthreads();
}

DEVI void phase_gateup(const Params& p, int l, char* smem) {
  const int tid = get_tid(), lane = tid & 63, wid = tid >> 6, wr = wid >> 1, wc = wid & 1;
  const unsigned* CNT = (const unsigned*)(p.ws + OFF_CNT) + l * 128;
  const unsigned* LIST = (const unsigned*)(p.ws + OFF_LIST);
  const u8* X8 = (const u8*)(p.ws + OFF_XA);
  const u8* WGU = (const u8*)(p.ws + OFF_WGU);
  u8* H = (u8*)(p.ws + OFF_H);
  int* tb = (int*)(smem + 65536);
  int* rowb = tb + 72;
  int* cnts = rowb + 72;
  build_tiles(CNT, tb, rowb, cnts);
  const int ntiles = tb[65];
  int e_nxt = 0, e_cur = 0;
  auto load_rows = [&](int it, int (&tokr)[4]) {
    const int rbt = it >> 2;
    int e = e_nxt;
    while (tb[e + 1] <= rbt) ++e;
    e_nxt = e;
    const int rb = rbt - tb[e], cnt = cnts[e];
#pragma unroll
    for (int q = 0; q < 4; ++q) {
      int r = rb * 128 + (tid >> 3) + 32 * q;
      r = r < cnt ? r : cnt - 1;
      tokr[q] = e < 64 ? (int)(LIST[(size_t)e * NTOK + r] >> 3) : r;
    }
  };
  const int rtc = (ntiles + 7) >> 3, it_step = gridDim.x >> 3;
  const int it_beg = (int)(blockIdx.x & 7) * rtc * 4 + (blockIdx.x >> 3);
  const int it_end = min(ntiles, ((int)(blockIdx.x & 7) + 1) * rtc) * 4;
  int tokn[4] = {0, 0, 0, 0};
  if (it_beg < it_end) load_rows(it_beg, tokn);
  for (int it = it_beg; it < it_end; it += it_step) {
    const int rbt = it >> 2, nt = it & 3;
    int e = e_cur;
    while (tb[e + 1] <= rbt) ++e;
    e_cur = e;
    const int rb = rbt - tb[e], cnt = cnts[e];
    long aoff[4];
#pragma unroll
    for (int q = 0; q < 4; ++q) aoff[q] = (long)tokn[q] * DM;
    if (it + it_step < it_end) load_rows(it + it_step, tokn);
    f32x4 acc[4][4];
    gemm128_f8(X8, aoff, WGU + (size_t)e * 512 * DM, DM, nt * 128, DM, smem, acc);
    const int g64 = nt * 2 + wc;
#pragma unroll
    for (int m = 0; m < 4; ++m) {
      const int r = rb * 128 + wr * 64 + m * 16 + (lane & 15);
      if (r < cnt) {
        u8* hrow = H + (size_t)(rowb[e] + r) * EH + g64 * 32;
        unsigned hv[2];
#pragma unroll
        for (int n = 0; n < 2; ++n) {
          float v[4];
#pragma unroll
          for (int q = 0; q < 4; ++q) {
            const float gt = acc[m][n][q] * (1.f / F8_SW), up = acc[m][n + 2][q] * (1.f / F8_SW);
            v[q] = gt * __builtin_amdgcn_rcpf(1.f + __expf(-gt)) * up * F8_SH;
          }
          hv[n] = pk4_f8c(v[0], v[1], v[2], v[3]);
        }
        *(uint2*)(hrow + 8 * (lane >> 4)) = make_uint2(hv[0], hv[1]);
      }
    }
  }
}

DEVI void phase_down(const Params& p, int l, char* smem, int pflags = 0) {
  const int tid = get_tid(), lane = tid & 63, wid = tid >> 6, wr = wid >> 1, wc = wid & 1;
  const unsigned* CNT = (const unsigned*)(p.ws + OFF_CNT) + l * 128;
  const unsigned* LIST = (const unsigned*)(p.ws + OFF_LIST);
  const float* LISTW = (const float*)(p.ws + OFF_LISTW);
  const u8* WD = (const u8*)(p.ws + OFF_WD);
  const u8* H = (const u8*)(p.ws + OFF_H);
  u8* Y = (u8*)(p.ws + OFF_Y);
  u8* YSH = (u8*)(p.ws + OFF_YSH);
  int* tb = (int*)(smem + 65536);
  int* rowb = tb + 72;
  int* cnts = rowb + 72;
  const int ntiles = tb[65];
  int e_nxt = 0, e_cur = 0;
  auto load_meta = [&](int it, unsigned (&pid)[4], float (&w)[4]) {
    const int rbt = it >> 1;
    int e = e_nxt;
    while (tb[e + 1] <= rbt) ++e;
    e_nxt = e;
    const int rb = rbt - tb[e], cnt = cnts[e];
#pragma unroll
    for (int m = 0; m < 4; ++m) {
      int r = rb * 128 + wr * 64 + m * 16 + (lane & 15);
      r = r < cnt ? r : cnt - 1;
      if (e < 64) { pid[m] = LIST[(size_t)e * NTOK + r]; w[m] = LISTW[(size_t)e * NTOK + r]; }
      else { pid[m] = (unsigned)r; w[m] = 1.f; }
    }
  };
  const int rtc = (ntiles + 7) >> 3, it_step = gridDim.x >> 3;
  const int it_beg = (int)(blockIdx.x & 7) * rtc * 2 + (blockIdx.x >> 3);
  const int it_end = min(ntiles, ((int)(blockIdx.x & 7) + 1) * rtc) * 2;
  unsigned pidn[4] = {0u, 0u, 0u, 0u};
  float wn[4] = {1.f, 1.f, 1.f, 1.f};
  if (it_beg < it_end) load_meta(it_beg, pidn, wn);
  for (int it = it_beg; it < it_end; it += it_step) {
    const int rbt = it >> 1, nh = it & 1;
    int e = e_cur;
    while (tb[e + 1] <= rbt) ++e;
    e_cur = e;
    const int rb = rbt - tb[e], cnt = cnts[e];
    long aoff[4];
#pragma unroll
    for (int q = 0; q < 4; ++q) aoff[q] = (long)(rowb[e] + rb * 128 + (tid >> 3) + 32 * q) * EH;
    u8* yrow[4];
    float wrow[4];
#pragma unroll
    for (int m = 0; m < 4; ++m) {
      const int r = rb * 128 + wr * 64 + m * 16 + (lane & 15);
      wrow[m] = wn[m];
      u8* dst = e < 64 ? Y + (size_t)pidn[m] * DM : YSH + (size_t)pidn[m] * DM;
      yrow[m] = (r < cnt && !(pflags & 32)) ? dst : (u8*)(p.ws + WS_NEED) + (size_t)(tid & 255) * DM;
    }
    if (it + it_step < it_end) load_meta(it + it_step, pidn, wn);
    gemm128_stream_f8<4>(H, aoff, WD + (size_t)e * DM * EH, EH, nh * 512, 4, EH, smem, [&](int tile, f32x4 (&acc)[4][4]) {
#pragma unroll
      for (int m = 0; m < 4; ++m) {
        const float w = wrow[m] * (F8_SY / (F8_SW * F8_SH));
        const int col0 = nh * 512 + tile * 128 + wc * 64 + 16 * (lane >> 4);
        uint4 v0;
        v0.x = pk4_f8c(acc[m][0][0] * w, acc[m][0][1] * w, acc[m][0][2] * w, acc[m][0][3] * w);
        v0.y = pk4_f8c(acc[m][1][0] * w, acc[m][1][1] * w, acc[m][1][2] * w, acc[m][1][3] * w);
        v0.z = pk4_f8c(acc[m][2][0] * w, acc[m][2][1] * w, acc[m][2][2] * w, acc[m][2][3] * w);
        v0.w = pk4_f8c(acc[m][3][0] * w, acc[m][3][1] * w, acc[m][3][2] * w, acc[m][3][3] * w);
        if (pflags & 64) {
          asm volatile("" ::"v"(v0.x), "v"(v0.y), "v"(v0.z), "v"(v0.w));
        } else {
          *(uint4*)(yrow[m] + col0) = v0;
        }
      }
      return !(pflags & 64);
    });
  }
}

DEVI void phase_combine(const Params& p, int l, char* smem) {
  const int tid = get_tid(), lane = tid & 63, wid = tid >> 6;
  const u16* XBr = (const u16*)(p.ws + OFF_XB);
  const u16* XLr = (const u16*)(p.ws + OFF_XL);
  const u8* Y = (const u8*)(p.ws + OFF_Y);
  const u8* YSH = (const u8*)(p.ws + OFF_YSH);
  float* XO = p.out;
  u16* XOB = (u16*)(p.ws + OFF_XBUF);
  u16* XB = (u16*)(p.ws + OFF_XB);
  const float* g2 = p.in[20] + l * DM;
  const float* b2 = p.in[21] + l * DM;
  typedef __attribute__((ext_vector_type(2))) float f32x2_;
  uint4 xh0[2], xh1[2];
  uint2 y0[2][9], y1[2][9];
#define CB_LOAD(XH, YV, TOK)                                                                       \
  {                                                                                                \
    _Pragma("unroll") for (int i = 0; i < 2; ++i) {                                                \
      const int c = lane * 8 + 512 * i;                                                            \
      XH[i] = *(const uint4*)(XBr + (TOK) * DM + c);                                               \
      _Pragma("unroll") for (int k = 0; k < 8; ++k) YV[i][k] = *(const uint2*)(Y + ((TOK) * 8 + k) * DM + c); \
      YV[i][8] = *(const uint2*)(YSH + (TOK) * DM + c);                                            \
    }                                                                                              \
  }
#define CB_PROC(XH, YV, TOK, LAST)                                                                 \
  {                                                                                                \
    float v[16];                                                                                   \
    _Pragma("unroll") for (int i = 0; i < 2; ++i) {                                                \
      float a[8] = {0.f, 0.f, 0.f, 0.f, 0.f, 0.f, 0.f, 0.f};                                       \
      _Pragma("unroll") for (int k = 0; k < 9; ++k) {                                              \
        const uint2 y = YV[i][k];                                                                  \
        const f32x2_ d0 = __builtin_amdgcn_cvt_pk_f32_fp8((int)y.x, false), d1 = __builtin_amdgcn_cvt_pk_f32_fp8((int)y.x, true); \
        const f32x2_ d2 = __builtin_amdgcn_cvt_pk_f32_fp8((int)y.y, false), d3 = __builtin_amdgcn_cvt_pk_f32_fp8((int)y.y, true); \
        a[0] += d0[0]; a[1] += d0[1]; a[2] += d1[0]; a[3] += d1[1];                                \
        a[4] += d2[0]; a[5] += d2[1]; a[6] += d3[0]; a[7] += d3[1];                                \
      }                                                                                            \
      const uint4 xh = XH[i];                                                                      \
      const float xs[8] = {__uint_as_float(xh.x << 16), __uint_as_float(xh.x & 0xffff0000u), __uint_as_float(xh.y << 16), __uint_as_float(xh.y & 0xffff0000u), \
                           __uint_as_float(xh.z << 16), __uint_as_float(xh.z & 0xffff0000u), __uint_as_float(xh.w << 16), __uint_as_float(xh.w & 0xffff0000u)}; \
      _Pragma("unroll") for (int j = 0; j < 8; ++j) v[8 * i + j] = ALPHA * xs[j] + a[j] * (1.f / F8_SY); \
    }                                                                                              \
    ln_row8(v, g2, b2, lane);                                                                      \
    _Pragma("unroll") for (int i = 0; i < 2; ++i) {                                                \
      const int c = lane * 8 + 512 * i;                                                            \
      if (LAST) {                                                                                  \
        *(float4*)(XO + (TOK) * DM + c) = make_float4(v[8 * i], v[8 * i + 1], v[8 * i + 2], v[8 * i + 3]);         \
        *(float4*)(XO + (TOK) * DM + c + 4) = make_float4(v[8 * i + 4], v[8 * i + 5], v[8 * i + 6], v[8 * i + 7]); \
      } else {                                                                                     \
        *(uint4*)(XOB + (TOK) * DM + c) = make_uint4(pk2(v[8 * i], v[8 * i + 1]), pk2(v[8 * i + 2], v[8 * i + 3]), \
                                                     pk2(v[8 * i + 4], v[8 * i + 5]), pk2(v[8 * i + 6], v[8 * i + 7])); \
        u8* xin8 = (u8*)(p.ws + OFF_XA + (32u << 20));                                             \
        *(uint2*)(xin8 + (TOK) * DM + c) = make_uint2(pk4_f8c(v[8 * i], v[8 * i + 1], v[8 * i + 2], v[8 * i + 3]), \
                                                      pk4_f8c(v[8 * i + 4], v[8 * i + 5], v[8 * i + 6], v[8 * i + 7])); \
      }                                                                                            \
    }                                                                                              \
  }
  const int gd = gridDim.x, nit = NTOK / 4;
#define CB_LOOP(LAST)                                                      \
  {                                                                        \
    int it = blockIdx.x;                                                   \
    if (it < nit) CB_LOAD(xh0, y0, (size_t)it * 4 + wid)                   \
    _Pragma("unroll 1") for (; it < nit; it += 2 * gd) {                   \
      const size_t tok = (size_t)it * 4 + wid, tokn = tok + (size_t)gd * 4; \
      const bool has1 = it + gd < nit;                                     \
      if (has1) CB_LOAD(xh1, y1, tokn)                                     \
      CB_PROC(xh0, y0, tok, LAST)                                          \
      if (has1) {                                                          \
        if (it + 2 * gd < nit) CB_LOAD(xh0, y0, tokn + (size_t)gd * 4)     \
        CB_PROC(xh1, y1, tokn, LAST)                                       \
      }                                                                    \
    }                                                                      \
  }
  if (l == NL - 1) CB_LOOP(true) else CB_LOOP(false)
#undef CB_LOOP
#undef CB_LOAD
#undef CB_PROC
}

constexpr int NPL = 10;
constexpr int NPHASE = 1 + NPL * NL;
constexpr int SMEM_BYTES = 66816;

#if MEGA
#define RUN_PHASE(S, CALL)                                              \
  {                                                                     \
    const int nrep_ = (pdup == (S)) ? 2 : 1;                            \
    for (int dup = 0; dup < nrep_; ++dup) {                             \
      Params p = pin;                                                   \
      asm volatile("" : "+s"(p.ws));   \
      CALL;                                                             \
      xcd_barrier(xb);                                                  \
    }                                                                   \
  }

#define RUN_PHASE_G(S, CALL)                                            \
  {                                                                     \
    const int nrep_ = (pdup == (S)) ? 2 : 1;                            \
    for (int dup = 0; dup < nrep_; ++dup) {                             \
      Params p = pin;                                                   \
      asm volatile("" : "+s"(p.ws));                                    \
      CALL;                                                             \
      XcdBarrier gb_;                                                   \
      gb_.bar = (unsigned*)(p.ws + OFF_BAR) + 4096 * (1 + (blockIdx.x & 7)); \
      gb_.x = xb.x; gb_.st = st + 2; gb_.G = (gridDim.x - (blockIdx.x & 7) + 7u) >> 3; \
      xcd_barrier(gb_);                                                 \
    }                                                                   \
  }

__global__ void __launch_bounds__(256, 2) fwd_kernel(Params pin, int pdup, int psub) {
  __shared__ __attribute__((aligned(16))) char smem[SMEM_BYTES];
  volatile LAS unsigned* st = (volatile LAS unsigned*)(smem + 66576);
  if (threadIdx.x == 0) { st[0] = 0u; st[1] = 0u; st[2] = 0u; st[3] = 0u; }
  __syncthreads();
  XcdBarrier xb = xcd_barrier_post((unsigned*)(pin.ws + OFF_BAR), st, gridDim.x);
  (void)xcd_barrier_post((unsigned*)(pin.ws + OFF_BAR) + 4096 * (1 + (blockIdx.x & 7)), st + 2,
                         (gridDim.x - (blockIdx.x & 7) + 7u) >> 3);
  {
    const int nrep_ = (pdup == 10) ? 2 : 1;
    for (int dup = 0; dup < nrep_; ++dup) {
      Params p = pin;
      asm volatile("" : "+s"(p.ws));
      phase_prep(p, smem);
      if (pdup == 0x7fffffff) cg::this_grid().sync();
      xcd_barrier(xb);
    }
  }
#pragma unroll 1
  for (int l = 0; l < NL; ++l) {
    RUN_PHASE_G(0, phase_inproj(p, l, smem))
    RUN_PHASE_G(2, phase_attn(p, l, smem))
    RUN_PHASE_G(4, phase_outproj(p, l, smem))
    RUN_PHASE(5, phase_ln1_router(p, l, smem, dup))
    RUN_PHASE_G(7, phase_gateup(p, l, smem))
    RUN_PHASE(8, phase_down(p, l, smem, dup ? psub : 0))
    RUN_PHASE(9, phase_combine(p, l, smem))
  }
}
#endif

extern "C" void kernel_launch(void* const* d_in, const int* in_sizes, int n_in, void* d_out, int out_size, void* d_ws,
                              size_t ws_size, hipStream_t stream) {
  if (ws_size < WS_NEED) fprintf(stderr, "workspace too small: %zu < %zu\n", ws_size, (size_t)WS_NEED);
  Params p{};
  for (int i = 0; i < 22; ++i) p.in[i] = (const float*)d_in[i];
  p.out = (float*)d_out;
  p.ws = (char*)d_ws;
#if MEGA
  static int grid_blocks = 0;
  if (!grid_blocks) {
    int dev = 0, cus = 0, per_cu = 0;
    (void)hipGetDevice(&dev);
    (void)hipDeviceGetAttribute(&cus, hipDeviceAttributeMultiprocessorCount, dev);
    (void)hipOccupancyMaxActiveBlocksPerMultiprocessor(&per_cu, fwd_kernel, 256, 0);
    if (per_cu > 2) per_cu = 2;
    if (per_cu < 1) per_cu = 1;
    grid_blocks = cus * per_cu;
    if (grid_blocks > MAXGRID) grid_blocks = MAXGRID;
  }
  (void)hipMemsetAsync((char*)d_ws + OFF_BAR, 0, BAR_BYTES, stream);
  int pdup = PROBE_DUP, psub = PROBE_SUB;
  void* args[] = {&p, &pdup, &psub};
  hipError_t e = hipLaunchCooperativeKernel((void*)fwd_kernel, dim3(grid_blocks), dim3(256), args, 0, stream);
  if (e != hipSuccess) fprintf(stderr, "cooperative launch failed: %s (grid %d)\n", hipGetErrorString(e), grid_blocks);
#endif
}
```
